# Optimizing an MI355X kernel written in HIP

```python
import jax, jax.numpy as jnp
from jax import lax
import numpy as np

D_MODEL = 1024
BATCH = 32
SEQ = 256
DEPTH = 2
DEC_BATCH = 4
DEC_SEQ = 1024
PAST_LEN = 256

GRID_W = 64
NA_HEADS = 8
NA_HEAD_DIM = 64
NA_WIDTH = NA_HEADS * NA_HEAD_DIM
NA_WIN_ROWS = 8
NA_WIN_COLS = 16
SSD_HEADS = 16
SSD_HEAD_DIM = 64
SSD_D_INNER = SSD_HEADS * SSD_HEAD_DIM
SSD_GROUPS = 2
SSD_STATE = 128
SSD_CONV = 5
SSD_XBC = SSD_D_INNER + 2 * SSD_GROUPS * SSD_STATE
RET_HEADS = 4
RET_QK_DIM = 256
RET_V_DIM = 512
RET_QK_W = RET_HEADS * RET_QK_DIM
RET_V_W = RET_HEADS * RET_V_DIM
SCAN_CHUNK = 64
FFN_HIDDEN = ((8 * D_MODEL + 3 * 256 - 1) // (3 * 256)) * 256
ROPE_BASE = 10000.0
EPS = 1e-6
L0_SPLITS = (NA_WIDTH, 2 * NA_WIDTH, 3 * NA_WIDTH, 3 * NA_WIDTH + SSD_D_INNER,
             3 * NA_WIDTH + SSD_D_INNER + SSD_XBC)
L0_IN = 3 * NA_WIDTH + SSD_D_INNER + SSD_XBC + 2 * SSD_HEADS
L0_MIX = NA_WIDTH + SSD_D_INNER
L1_SPLITS = (RET_QK_W, 2 * RET_QK_W, 2 * RET_QK_W + RET_V_W)
L1_IN = 2 * RET_QK_W + 2 * RET_V_W

kernel_name = "hybrid_na_ssd_retention_diffusion_step"

F32 = jnp.float32


def rmsnorm(x, w):
    x32 = x.astype(F32)
    y = x32 * lax.rsqrt(jnp.mean(x32 * x32, axis=-1, keepdims=True) + EPS)
    return (y * w.astype(F32)).astype(x.dtype)


def adaln(cond, mod_w, mod_b):
    mod = jax.nn.silu(cond) @ mod_w + mod_b
    if mod.ndim == 2:
        mod = mod[:, None, :]
    return jnp.split(mod, 6, axis=-1)


def swiglu(h, w1, w3, w2):
    return (jax.nn.silu(h @ w1) * (h @ w3)) @ w2


def axial_rope(x):
    l, dh = x.shape[1], x.shape[-1]
    t = jnp.arange(l)
    row = (t // GRID_W).astype(F32)
    col = (t % GRID_W).astype(F32)
    half = dh // 2
    freqs = ROPE_BASE ** (-jnp.arange(0, half, 2, dtype=F32) / half)
    ang = jnp.concatenate([row[:, None] * freqs, col[:, None] * freqs], axis=-1)
    cos, sin = jnp.cos(ang)[:, None, :], jnp.sin(ang)[:, None, :]
    xr = x.astype(F32).reshape(x.shape[:-1] + (dh // 2, 2))
    x1, x2 = xr[..., 0], xr[..., 1]
    out = jnp.stack([x1 * cos - x2 * sin, x1 * sin + x2 * cos], axis=-1)
    return out.reshape(x.shape).astype(x.dtype)


def chunked_scan(q, k, v, log_a, s0):
    b, l, h, dk = q.shape
    dv = v.shape[-1]
    nc = l // SCAN_CHUNK

    def to_chunks(t):
        return jnp.moveaxis(t.astype(F32).reshape((b, nc, SCAN_CHUNK) + t.shape[2:]), 1, 0)

    lower = jnp.tril(jnp.ones((SCAN_CHUNK, SCAN_CHUNK), bool))[None, :, :, None]

    def step(s, inp):
        qi, ki, vi, ai = inp
        cs = jnp.cumsum(ai, axis=1)
        diff = cs[:, :, None, :] - cs[:, None, :, :]
        decay = jnp.exp(jnp.where(lower, diff, -jnp.inf))
        scores = jnp.einsum('bihd,bjhd->bijh', qi, ki) * decay
        y = jnp.einsum('bijh,bjhe->bihe', scores, vi)
        y = y + jnp.einsum('bihd,bhde->bihe', qi * jnp.exp(cs)[..., None], s)
        tail = jnp.exp(cs[:, -1:, :] - cs)
        s_new = (jnp.exp(cs[:, -1, :])[:, :, None, None] * s
                 + jnp.einsum('bjhd,bjhe->bhde', ki * tail[..., None], vi))
        return s_new, y

    s_fin, ys = lax.scan(step, s0.astype(F32), (to_chunks(q), to_chunks(k), to_chunks(v), to_chunks(log_a)))
    return jnp.moveaxis(ys, 0, 1).reshape(b, l, h, dv), s_fin


def bidir_scan(q, k, v_f, v_b, a_f, a_b, s0):
    flip = lambda t: jnp.flip(t, axis=1)
    y_f, s_f = chunked_scan(q, k, v_f, a_f, s0[:, 0])
    y_b, s_b = chunked_scan(flip(q), flip(k), flip(v_b), flip(a_b), s0[:, 1])
    return y_f + flip(y_b), jnp.stack([s_f, s_b], axis=1)


def depthwise_conv(x, w, b):
    pad = SSD_CONV // 2
    out = lax.conv_general_dilated(x, w[:, None, :].astype(x.dtype), window_strides=(1,),
                                   padding=[(pad, pad)], dimension_numbers=('NWC', 'WIO', 'NWC'),
                                   feature_group_count=x.shape[-1])
    return out + b


def ssd_mixer(z, xbc, dt_raw, conv_w, conv_b, a_log, dt_bias, d_skip, norm_w, s0):
    b, l, _ = z.shape
    xbc = jax.nn.silu(depthwise_conv(xbc, conv_w, conv_b)).astype(F32)
    xs, bs, cs = jnp.split(xbc, (SSD_D_INNER, SSD_D_INNER + SSD_GROUPS * SSD_STATE), axis=-1)
    rep = SSD_HEADS // SSD_GROUPS
    xh = xs.reshape(b, l, SSD_HEADS, SSD_HEAD_DIM)
    bh = jnp.repeat(bs.reshape(b, l, SSD_GROUPS, SSD_STATE), rep, axis=2)
    ch = jnp.repeat(cs.reshape(b, l, SSD_GROUPS, SSD_STATE), rep, axis=2)
    dt = jax.nn.softplus(dt_raw.astype(F32) + dt_bias.astype(F32))
    log_a = dt * (-jnp.exp(a_log.astype(F32)))
    y, s_fin = bidir_scan(ch, bh, xh * dt[:, :, 0, :, None], xh * dt[:, :, 1, :, None],
                          log_a[:, :, 0], log_a[:, :, 1], s0)
    y = y + d_skip.astype(F32)[:, None] * xh
    y = y.reshape(b, l, SSD_D_INNER) * jax.nn.silu(z.astype(F32))
    yg = y.reshape(b, l, SSD_GROUPS, SSD_D_INNER // SSD_GROUPS)
    yg = yg * lax.rsqrt(jnp.mean(yg * yg, axis=-1, keepdims=True) + EPS)
    return yg.reshape(b, l, SSD_D_INNER) * norm_w.astype(F32), s_fin


def na_context(q, k, v):
    s = jnp.einsum('blhd,bmhd->bhlm', q, k).astype(F32) * NA_HEAD_DIM ** -0.5
    p = jax.nn.softmax(s, axis=-1).astype(v.dtype)
    return jnp.einsum('bhlm,bmhd->blhd', p, v)


def na_latent(q, k, v, k_ctx, v_ctx, rel_bias):
    b, l, h, d = q.shape
    rows = l // GRID_W
    wr = min(NA_WIN_ROWS, rows)
    r = jnp.arange(rows)
    r0 = jnp.clip(r - wr // 2, 0, rows - wr)
    band_rows = r0[:, None] + jnp.arange(wr)
    kg = k.reshape(b, rows, GRID_W, h, d)[:, band_rows]
    vg = v.reshape(b, rows, GRID_W, h, d)[:, band_rows]
    qg = q.reshape(b, rows, GRID_W, h, d)
    scale = NA_HEAD_DIM ** -0.5
    s_loc = jnp.einsum('brchd,brswhd->bhrcsw', qg, kg).astype(F32) * scale
    col = jnp.arange(GRID_W)
    c0 = jnp.clip(col - NA_WIN_COLS // 2, 0, GRID_W - NA_WIN_COLS)
    col_in = (col[None, :] >= c0[:, None]) & (col[None, :] < c0[:, None] + NA_WIN_COLS)
    dr_idx = band_rows - r[:, None] + NA_WIN_ROWS - 1
    dc_idx = jnp.clip(col[None, :] - col[:, None] + NA_WIN_COLS - 1, 0, 2 * NA_WIN_COLS - 2)
    bias = rel_bias.astype(F32)[:, dr_idx[:, None, :, None], dc_idx[None, :, None, :]]
    s_loc = jnp.where(col_in[:, None, :], s_loc + bias[None], -jnp.inf)
    s_ctx = jnp.einsum('brchd,bmhd->bhrcm', qg, k_ctx).astype(F32) * scale
    n_loc = wr * GRID_W
    s_all = jnp.concatenate([s_loc.reshape(b, h, rows, GRID_W, n_loc), s_ctx], axis=-1)
    p = jax.nn.softmax(s_all, axis=-1).astype(v.dtype)
    p_loc = p[..., :n_loc].reshape(b, h, rows, GRID_W, wr, GRID_W)
    out = (jnp.einsum('bhrcsw,brswhd->brchd', p_loc, vg)
           + jnp.einsum('bhrcm,bmhd->brchd', p[..., n_loc:], v_ctx))
    return out.reshape(b, l, h, d)


def even_mixer(h, w_in, w_out, na_bias, conv_w, conv_b, a_log, dt_bias, d_skip, norm_w, cache):
    b, l, _ = h.shape
    q, k, v, z, xbc, dt_raw = jnp.split(h @ w_in, L0_SPLITS, axis=-1)
    heads = lambda t: t.reshape(b, l, NA_HEADS, NA_HEAD_DIM)
    q, k, v = heads(q), heads(k), heads(v)
    if cache is None:
        att = na_context(q, k, v)
        s0 = jnp.zeros((b, 2, SSD_HEADS, SSD_STATE, SSD_HEAD_DIM), F32)
    else:
        k_ctx, v_ctx, s0 = cache
        att = na_latent(q, k, v, k_ctx, v_ctx, na_bias)
    ssd, s_fin = ssd_mixer(z, xbc, dt_raw.reshape(b, l, 2, SSD_HEADS), conv_w, conv_b,
                           a_log, dt_bias, d_skip, norm_w, s0)
    mixed = jnp.concatenate([att.reshape(b, l, NA_WIDTH), ssd.astype(h.dtype)], axis=-1)
    return mixed @ w_out, (k, v, s_fin)


def odd_mixer(h, w_in, w_out, ret_decay, ret_norm_w, cache):
    b, l, _ = h.shape
    q, k, v, g = jnp.split(h @ w_in, L1_SPLITS, axis=-1)
    q = q.reshape(b, l, RET_HEADS, RET_QK_DIM)
    k = k.reshape(b, l, RET_HEADS, RET_QK_DIM) * RET_QK_DIM ** -0.5
    v = v.reshape(b, l, RET_HEADS, RET_V_DIM)
    if cache is None:
        s0 = jnp.zeros((b, 2, RET_HEADS, RET_QK_DIM, RET_V_DIM), F32)
    else:
        q, k, s0 = axial_rope(q), axial_rope(k), cache
    log_g = jax.nn.log_sigmoid(ret_decay.astype(F32))
    a_f = jnp.broadcast_to(log_g[0], (b, l, RET_HEADS))
    a_b = jnp.broadcast_to(log_g[1], (b, l, RET_HEADS))
    y, s_fin = bidir_scan(q, k, v, v, a_f, a_b, s0)
    y = y * lax.rsqrt(jnp.mean(y * y, axis=-1, keepdims=True) + EPS)
    y = y.reshape(b, l, RET_V_W) * ret_norm_w.astype(F32) * jax.nn.silu(g.astype(F32))
    return y.astype(h.dtype) @ w_out, s_fin


def block(x, cond, mixer, norm1_w, norm2_w, mod_w, mod_b, w1, w3, w2):
    sh1, sc1, g1, sh2, sc2, g2 = adaln(cond, mod_w, mod_b)
    out, aux = mixer(rmsnorm(x, norm1_w) * (1 + sc1) + sh1)
    x = x + g1 * out
    x = x + g2 * swiglu(rmsnorm(x, norm2_w) * (1 + sc2) + sh2, w1, w3, w2)
    return x, aux


def setup_inputs(seed: int = 0) -> dict:
    key = jax.random.key(seed)
    ks = iter(jax.random.split(key, 64))
    D = D_MODEL
    nrm = lambda shape, scale: jax.random.normal(next(ks), shape, F32) * scale
    uni = lambda shape, lo, hi: jax.random.uniform(next(ks), shape, F32, lo, hi)
    inp = {}
    inp['x_prompt'] = nrm((BATCH, SEQ, D), 1.0)
    inp['x_sample'] = nrm((DEC_BATCH, DEC_SEQ, D), 1.0)
    inp['cache_l0_na_k'] = nrm((DEC_BATCH, PAST_LEN, NA_HEADS, NA_HEAD_DIM), 1.0)
    inp['cache_l0_na_v'] = nrm((DEC_BATCH, PAST_LEN, NA_HEADS, NA_HEAD_DIM), 1.0)
    inp['state_l0_ssd'] = nrm((DEC_BATCH, 2, SSD_HEADS, SSD_STATE, SSD_HEAD_DIM), 0.1)
    inp['state_l1_ret'] = nrm((DEC_BATCH, 2, RET_HEADS, RET_QK_DIM, RET_V_DIM), 0.1)
    inp['c'] = nrm((DEC_BATCH, D), 1.0)
    inp['c_ctx'] = nrm((D,), 1.0)
    inp['l0_norm1_w'] = 1.0 + nrm((D,), 0.02)
    inp['l0_norm2_w'] = 1.0 + nrm((D,), 0.02)
    inp['l0_mod_w'] = nrm((D, 6 * D), 0.5 * D ** -0.5)
    inp['l0_mod_b'] = nrm((6 * D,), 0.02)
    inp['l0_w_in'] = jnp.concatenate([nrm((D, L0_IN - 2 * SSD_HEADS), D ** -0.5),
                                      nrm((D, 2 * SSD_HEADS), 0.1 * D ** -0.5)], axis=1)
    inp['l0_w_out'] = nrm((L0_MIX, D), L0_MIX ** -0.5)
    inp['l0_na_bias'] = nrm((NA_HEADS, 2 * NA_WIN_ROWS - 1, 2 * NA_WIN_COLS - 1), 0.02)
    inp['l0_conv_w'] = nrm((SSD_CONV, SSD_XBC), SSD_CONV ** -0.5)
    inp['l0_conv_b'] = nrm((SSD_XBC,), 0.02)
    inp['l0_ssd_a_log'] = jnp.log(uni((2, SSD_HEADS), 1.0, 16.0))
    dt0 = jnp.exp(uni((2, SSD_HEADS), float(np.log(1e-3)), float(np.log(1e-1))))
    inp['l0_ssd_dt_bias'] = dt0 + jnp.log(-jnp.expm1(-dt0))
    inp['l0_ssd_d'] = 1.0 + nrm((SSD_HEADS,), 0.1)
    inp['l0_ssd_norm_w'] = 1.0 + nrm((SSD_D_INNER,), 0.02)
    inp['l0_ffn_w1'] = nrm((D, FFN_HIDDEN), D ** -0.5)
    inp['l0_ffn_w3'] = nrm((D, FFN_HIDDEN), D ** -0.5)
    inp['l0_ffn_w2'] = nrm((FFN_HIDDEN, D), FFN_HIDDEN ** -0.5)
    inp['l1_norm1_w'] = 1.0 + nrm((D,), 0.02)
    inp['l1_norm2_w'] = 1.0 + nrm((D,), 0.02)
    inp['l1_mod_w'] = nrm((D, 6 * D), 0.5 * D ** -0.5)
    inp['l1_mod_b'] = nrm((6 * D,), 0.02)
    inp['l1_w_in'] = nrm((D, L1_IN), D ** -0.5)
    inp['l1_w_out'] = nrm((RET_V_W, D), RET_V_W ** -0.5)
    gamma = 1.0 - 2.0 ** (-5.0 - np.arange(RET_HEADS, dtype=np.float32))
    logit = np.log(gamma) - np.log1p(-gamma)
    inp['l1_ret_decay'] = jnp.asarray(logit, F32)[None, :] + nrm((2, RET_HEADS), 0.1)
    inp['l1_ret_norm_w'] = 1.0 + nrm((RET_V_W,), 0.02)
    inp['l1_ffn_w1'] = nrm((D, FFN_HIDDEN), D ** -0.5)
    inp['l1_ffn_w3'] = nrm((D, FFN_HIDDEN), D ** -0.5)
    inp['l1_ffn_w2'] = nrm((FFN_HIDDEN, D), FFN_HIDDEN ** -0.5)
    inp['final_norm_w'] = 1.0 + nrm((D,), 0.02)
    return inp


def reference(x_prompt, x_sample, cache_l0_na_k, cache_l0_na_v, state_l0_ssd, state_l1_ret, c, c_ctx,
              l0_norm1_w, l0_norm2_w, l0_mod_w, l0_mod_b, l0_w_in, l0_w_out, l0_na_bias, l0_conv_w, l0_conv_b,
              l0_ssd_a_log, l0_ssd_dt_bias, l0_ssd_d, l0_ssd_norm_w, l0_ffn_w1, l0_ffn_w3, l0_ffn_w2,
              l1_norm1_w, l1_norm2_w, l1_mod_w, l1_mod_b, l1_w_in, l1_w_out, l1_ret_decay, l1_ret_norm_w,
              l1_ffn_w1, l1_ffn_w3, l1_ffn_w2, final_norm_w):
    mixers = [
        lambda h, cache: even_mixer(h, l0_w_in, l0_w_out, l0_na_bias, l0_conv_w, l0_conv_b, l0_ssd_a_log,
                                    l0_ssd_dt_bias, l0_ssd_d, l0_ssd_norm_w, cache),
        lambda h, cache: odd_mixer(h, l1_w_in, l1_w_out, l1_ret_decay, l1_ret_norm_w, cache),
    ]
    block_w = [
        (l0_norm1_w, l0_norm2_w, l0_mod_w, l0_mod_b, l0_ffn_w1, l0_ffn_w3, l0_ffn_w2),
        (l1_norm1_w, l1_norm2_w, l1_mod_w, l1_mod_b, l1_ffn_w1, l1_ffn_w3, l1_ffn_w2),
    ]
    caches = [(cache_l0_na_k, cache_l0_na_v, state_l0_ssd), state_l1_ret]

    xc = x_prompt
    ctx_out = []
    for i in range(DEPTH):
        xc, aux = block(xc, c_ctx, lambda h: mixers[i](h, None), *block_w[i])
        ctx_out.append(aux)

    xs = x_sample
    for i in range(DEPTH):
        xs, _ = block(xs, c, lambda h: mixers[i](h, caches[i]), *block_w[i])

    y_prompt = rmsnorm(xc, final_norm_w)
    y_sample = rmsnorm(xs, final_norm_w)
    (new_l0_na_k, new_l0_na_v, new_l0_ssd), new_l1_ret = ctx_out[0], ctx_out[1]
    return (y_prompt, y_sample, new_l0_na_k, new_l0_na_v, new_l0_ssd, new_l1_ret)
```

```cpp
#include <hip/hip_runtime.h>
#include <hip/hip_cooperative_groups.h>
#include <cstdio>
#include <cstdint>
namespace cg = cooperative_groups;

#ifndef N_SPLIT
#define N_SPLIT 0
#endif

#define LAS __attribute__((address_space(3)))
typedef unsigned short bf16_t;
typedef short bf16x8 __attribute__((ext_vector_type(8)));
typedef float f32x4 __attribute__((ext_vector_type(4)));
typedef unsigned u32x4 __attribute__((ext_vector_type(4)));
typedef unsigned u32x2 __attribute__((ext_vector_type(2)));

constexpr int T = 12288, TC = 8192, DM = 1024;
constexpr int NTHR = 512;
constexpr int LDS_BYTES = 163840;
constexpr int LDS_XB_OFF = LDS_BYTES - 16;
constexpr int FFN = 2816;

constexpr size_t al256(size_t x) { return (x + 255) & ~(size_t)255; }
constexpr size_t O_CTL   = 0;
constexpr size_t O_MOD   = 16384;
constexpr size_t O_W0IN  = al256(O_MOD + 2 * 5 * 6144 * 4);
constexpr size_t O_W0OUT = O_W0IN + (size_t)4352 * 1024 * 2;
constexpr size_t O_W0UP  = O_W0OUT + (size_t)1024 * 1536 * 2;
constexpr size_t O_W0DN  = O_W0UP + (size_t)5632 * 1024 * 2;
constexpr size_t O_W1IN  = O_W0DN + (size_t)1024 * 2816 * 2;
constexpr size_t O_W1OUT = O_W1IN + (size_t)6144 * 1024 * 2;
constexpr size_t O_W1UP  = O_W1OUT + (size_t)1024 * 2048 * 2;
constexpr size_t O_W1DN  = O_W1UP + (size_t)5632 * 1024 * 2;
constexpr size_t O_CK    = O_W1DN + (size_t)1024 * 2816 * 2;
constexpr size_t O_CVT   = O_CK + (size_t)4 * 256 * 512 * 2;
constexpr size_t O_H     = O_CVT + (size_t)4 * 512 * 256 * 2;
constexpr size_t O_XA    = O_H + (size_t)T * 1024 * 2;
constexpr size_t O_Q0    = O_XA + (size_t)T * 1024 * 4;
constexpr size_t O_K0    = O_Q0 + (size_t)T * 512 * 2;
constexpr size_t O_V0T   = O_K0 + (size_t)T * 512 * 2;
constexpr size_t O_Z     = O_V0T + (size_t)T * 512 * 2;
constexpr size_t O_XBC   = O_Z + (size_t)T * 1024 * 2;
constexpr size_t O_DT    = O_XBC + (size_t)T * 1536 * 2;
constexpr size_t O_XC    = O_DT + (size_t)T * 32 * 4;
constexpr size_t O_XT    = O_XC + (size_t)T * 1536 * 2;
constexpr size_t O_YS    = O_XT + (size_t)1280 * T * 2;
constexpr size_t O_MIX   = O_YS + (size_t)2 * T * 1024 * 2;
constexpr size_t O_HID   = O_MIX + (size_t)T * 1536 * 2;
constexpr size_t O_QR    = O_HID + (size_t)T * 2816 * 2;
constexpr size_t O_KR    = O_QR + (size_t)T * 1024 * 2;
constexpr size_t O_KRT   = O_KR + (size_t)T * 1024 * 2;
constexpr size_t O_VRT   = O_KRT + (size_t)T * 1024 * 2;
constexpr size_t O_GR    = O_VRT + (size_t)T * 2048 * 2;
constexpr size_t O_YR    = O_GR + (size_t)T * 2048 * 2;
constexpr size_t O_RG    = O_YR + (size_t)2 * T * 2048 * 2;
constexpr size_t O_GP    = O_RG + (size_t)T * 2048 * 2;
constexpr size_t WS_END  = O_GP + (size_t)192 * 4 * 16 * 256 * 4;

constexpr size_t OUT_Y = 0, OUT_K = (size_t)T * 1024, OUT_V = OUT_K + (size_t)TC * 512, OUT_SSD = OUT_V + (size_t)TC * 512,
                 OUT_RET = OUT_SSD + (size_t)32 * 2 * 16 * 128 * 64;

struct Params { const float* in[36]; float* out; unsigned char* ws; int ph_lo, ph_hi; };

typedef float f32x2 __attribute__((ext_vector_type(2)));
typedef __bf16 nbf16x2 __attribute__((ext_vector_type(2)));
__device__ __forceinline__ unsigned cvt_pk_bf16(float lo, float hi) { const f32x2 v = {lo, hi}; const nbf16x2 b = __builtin_convertvector(v, nbf16x2); return __builtin_bit_cast(unsigned, b); }
__device__ __forceinline__ bf16_t f2bf(float x) { return (bf16_t)(cvt_pk_bf16(x, 0.f) & 0xffffu); }
__device__ __forceinline__ float bf_lo(unsigned w) { return __uint_as_float(w << 16); }
__device__ __forceinline__ float bf_hi(unsigned w) { return __uint_as_float(w & 0xffff0000u); }
__device__ __forceinline__ float bf2f(bf16_t b) { return __uint_as_float((unsigned)b << 16); }
__device__ __forceinline__ LAS unsigned char* opq(LAS unsigned char* p) { asm volatile("" : "+v"(p)); return p; }
__device__ __forceinline__ void unpack8(u32x4 w, float (&x)[8]) { x[0] = bf_lo(w.x); x[1] = bf_hi(w.x); x[2] = bf_lo(w.y); x[3] = bf_hi(w.y); x[4] = bf_lo(w.z); x[5] = bf_hi(w.z); x[6] = bf_lo(w.w); x[7] = bf_hi(w.w); }
__device__ __forceinline__ float siluf(float x) { return x * __builtin_amdgcn_rcpf(1.f + __expf(-x)); }
__device__ __forceinline__ float softplusf(float x) { return x > 20.f ? x : log1pf(__expf(x)); }
__device__ __forceinline__ bf16x8 as_bf16x8(u32x4 v) { return __builtin_bit_cast(bf16x8, v); }
__device__ __forceinline__ f32x4 mfma16(bf16x8 a, bf16x8 b, f32x4 c) { return __builtin_amdgcn_mfma_f32_16x16x32_bf16(a, b, c, 0, 0, 0); }
__device__ __forceinline__ float wave_sum(float v) {
#pragma unroll
    for (int o = 32; o >= 1; o >>= 1) v += __shfl_xor(v, o);
    return v;
}

constexpr int BM = 256, BK = 64, HALF = 128, HTB = HALF * BK * 2;
__device__ __forceinline__ int lds_byte(int r, int c) { const int st = (r >> 4) * 2 + (c >> 5), rr = r & 15, cc = c & 31, ob = rr * 64 + cc * 2; return st * 1024 + (ob ^ (((ob >> 9) & 1) << 5)); }
__device__ __forceinline__ void stage_rc(int b, int& R, int& C) { const int st = b / 1024, sb = b % 1024, swz = sb ^ (((sb >> 9) & 1) << 5); R = (st >> 1) * 16 + swz / 64; C = (st & 1) * 32 + (swz % 64) / 2; }

__device__ __forceinline__ bool tile_of(int L, int nM, int nN, int& pm, int& pn) {
    const int nwg = nM * nN; if (L >= nwg) return false;
    int wgid = L; { const int q = nwg / 8, r = nwg % 8, xcd = wgid % 8, off = wgid / 8; wgid = (xcd < r ? xcd * (q + 1) : r * (q + 1) + (xcd - r) * q) + off; }
    const int nig = 8 * nN, gid = wgid / nig, fm = gid * 8, gsz = (nM - fm) < 8 ? (nM - fm) : 8;
    pm = fm + ((wgid % nig) % gsz); pn = (wgid % nig) / gsz; return true;
}

template <class Epi>
__device__ __forceinline__ void gemm_tile(LAS unsigned char* lds, const bf16_t* __restrict__ A, const bf16_t* __restrict__ Bt, const int K, const int brow, const int bcol, const Epi& epi) {
    const int tid = threadIdx.x, wid = __builtin_amdgcn_readfirstlane(tid >> 6), lane = tid & 63, wr = wid >> 2, wc = wid & 3, fr = lane & 15, fq = lane >> 4;
    unsigned voff[2], voffB[2];
#pragma unroll
    for (int i = 0; i < 2; ++i) { int R, C; stage_rc(tid * 16 + i * 8192, R, C); voff[i] = (unsigned)(R * K + C) * 2u;
        const int rho = R & 31, Rb = (R & ~31) + 8 * ((rho & 15) >> 2) + 4 * (rho >> 4) + (rho & 3); voffB[i] = (unsigned)(Rb * K + C) * 2u; }
    const unsigned ldsw = (unsigned)wid * 1024u;
    const int aoff = lds_byte(wr * 64 + fr, fq * 8), boff = lds_byte(wc * 32 + fr, fq * 8);
    const char* cA = (const char*)(A + (size_t)brow * K); const char* cB = (const char*)(Bt + (size_t)bcol * K);
    const size_t kstep = (size_t)BK * 2, hstep = (size_t)HALF * K * 2;
#define SA(b, h) (((b) * 2 + (h)) * HTB)
#define SB(b, h) ((4 + (b) * 2 + (h)) * HTB)
#define STAGE(bufoff, gbase) do { _Pragma("unroll") for (int _i = 0; _i < 2; ++_i) \
        __builtin_amdgcn_global_load_lds((const unsigned*)((gbase) + ((bufoff) >= 4 * HTB ? voffB[_i] : voff[_i])), (LAS unsigned*)(lds + (bufoff) + ldsw + _i * 8192), 16, 0, 0); } while (0)
#define LDA(dst, b, h) do { _Pragma("unroll") for (int m = 0; m < 4; ++m) _Pragma("unroll") for (int k = 0; k < 2; ++k) dst[m][k] = *(const LAS bf16x8*)(lds + SA(b, h) + aoff + m * 2048 + k * 1024); } while (0)
#define LDB(dst, b, h) do { _Pragma("unroll") for (int n = 0; n < 2; ++n) _Pragma("unroll") for (int k = 0; k < 2; ++k) dst[n][k] = *(const LAS bf16x8*)(lds + SB(b, h) + boff + n * 2048 + k * 1024); } while (0)
#define MMA(ai, bj, At, Bt_) do { __builtin_amdgcn_s_setprio(1); _Pragma("unroll") for (int m = 0; m < 4; ++m) _Pragma("unroll") for (int n = 0; n < 2; ++n) _Pragma("unroll") for (int k = 0; k < 2; ++k) \
        acc[ai][bj][m][n] = __builtin_amdgcn_mfma_f32_16x16x32_bf16(Bt_[n][k], At[m][k], acc[ai][bj][m][n], 0, 0, 0); __builtin_amdgcn_s_setprio(0); } while (0)
#define WAIT_V(n) asm volatile("s_waitcnt vmcnt(" #n ")" ::: "memory")
#define WAIT_L(n) asm volatile("s_waitcnt lgkmcnt(" #n ")" ::: "memory")
#define BAR __builtin_amdgcn_s_barrier()
#define SCHED __builtin_amdgcn_sched_barrier(0)
    f32x4 acc[2][2][4][2];
#pragma unroll
    for (int a = 0; a < 2; ++a)
#pragma unroll
        for (int b = 0; b < 2; ++b)
#pragma unroll
            for (int m = 0; m < 4; ++m)
#pragma unroll
                for (int n = 0; n < 2; ++n) acc[a][b][m][n] = (f32x4){0.f, 0.f, 0.f, 0.f};
    bf16x8 At[4][2], B0[2][2], B1[2][2];
    const int nt = K / BK;
    STAGE(SB(0, 0), cB); STAGE(SA(0, 0), cA); STAGE(SB(0, 1), cB + hstep); STAGE(SA(0, 1), cA + hstep);
    if (wr == 1) BAR;
    WAIT_V(4); BAR;
    STAGE(SB(1, 0), cB + kstep); STAGE(SA(1, 0), cA + kstep); STAGE(SB(1, 1), cB + hstep + kstep);
    WAIT_V(6); BAR;
    for (int t = 0; t < nt - 2; t += 2) {
        const char* a1 = cA + (size_t)(t + 1) * kstep; const char* a2 = cA + (size_t)(t + 2) * kstep; const char* b2 = cB + (size_t)(t + 2) * kstep;
        const char* a3 = a2 + kstep; const char* b3 = b2 + kstep;
        LDB(B0, 0, 0); SCHED; LDA(At, 0, 0); STAGE(SA(1, 1), a1 + hstep);
        WAIT_L(8); BAR; WAIT_L(0); MMA(0, 0, At, B0); BAR; SCHED;
        LDB(B1, 0, 1); STAGE(SB(0, 0), b2);
        BAR; WAIT_L(0); MMA(0, 1, At, B1); BAR;
        LDA(At, 0, 1); STAGE(SA(0, 0), a2);
        BAR; WAIT_L(0); MMA(1, 0, At, B0); BAR; SCHED;
        STAGE(SB(0, 1), b2 + hstep);
        WAIT_V(6); BAR; MMA(1, 1, At, B1); BAR;
        LDB(B0, 1, 0); SCHED; LDA(At, 1, 0); STAGE(SA(0, 1), a2 + hstep);
        WAIT_L(8); BAR; WAIT_L(0); MMA(0, 0, At, B0); BAR; SCHED;
        LDB(B1, 1, 1); STAGE(SB(1, 0), b3);
        BAR; WAIT_L(0); MMA(0, 1, At, B1); BAR;
        LDA(At, 1, 1); STAGE(SA(1, 0), a3);
        BAR; WAIT_L(0); MMA(1, 0, At, B0); BAR; SCHED;
        STAGE(SB(1, 1), b3 + hstep);
        WAIT_V(6); BAR; MMA(1, 1, At, B1); BAR;
    }
    { const char* a1 = cA + (size_t)(nt - 1) * kstep;
      LDB(B0, 0, 0); LDA(At, 0, 0); STAGE(SA(1, 1), a1 + hstep);
      BAR; WAIT_L(0); MMA(0, 0, At, B0); BAR;
      LDB(B1, 0, 1); BAR; WAIT_L(0); MMA(0, 1, At, B1); BAR;
      LDA(At, 0, 1); WAIT_V(4); BAR; WAIT_L(0); MMA(1, 0, At, B0); MMA(1, 1, At, B1); BAR; }
    { LDB(B0, 1, 0); LDA(At, 1, 0); WAIT_V(2); BAR; WAIT_L(0); MMA(0, 0, At, B0); BAR;
      LDB(B1, 1, 1); WAIT_V(0); BAR; WAIT_L(0); MMA(0, 1, At, B1); BAR;
      LDA(At, 1, 1); BAR; WAIT_L(0); MMA(1, 0, At, B0); MMA(1, 1, At, B1); BAR; }
    if (wr == 0) BAR;
    epi(acc, brow, bcol, wr, wc, fr, fq);
    WAIT_V(0);
    __syncthreads();
#undef SA
#undef SB
#undef STAGE
#undef LDA
#undef LDB
#undef MMA
#undef WAIT_V
#undef WAIT_L
#undef BAR
#undef SCHED
}

template <class F>
__device__ __forceinline__ void epi_each(const f32x4 (&acc)[2][2][4][2], int brow, int bcol, int wr, int wc, int fr, int fq, F f) {
#pragma unroll
    for (int ai = 0; ai < 2; ++ai)
#pragma unroll
        for (int m = 0; m < 4; ++m)
#pragma unroll
            for (int bj = 0; bj < 2; ++bj) f(brow + ai * 128 + wr * 64 + m * 16 + fr, bcol + bj * 128 + wc * 32 + fq * 8, acc[ai][bj][m][0], acc[ai][bj][m][1]);
}
__device__ __forceinline__ void st_bf16x4(bf16_t* p, f32x4 v) { u32x2 w; w.x = cvt_pk_bf16(v[0], v[1]); w.y = cvt_pk_bf16(v[2], v[3]); *(u32x2*)p = w; }
__device__ __forceinline__ void st_bf16x8(bf16_t* p, f32x4 a, f32x4 b) { u32x4 w; w.x = cvt_pk_bf16(a[0], a[1]); w.y = cvt_pk_bf16(a[2], a[3]); w.z = cvt_pk_bf16(b[0], b[1]); w.w = cvt_pk_bf16(b[2], b[3]); *(u32x4*)p = w; }
__device__ __forceinline__ void st_bf16_T(bf16_t* base, size_t col, int row, f32x4 v) {
#pragma unroll
    for (int j = 0; j < 4; ++j) base[(col + j) * (size_t)T + row] = f2bf(v[j]);
}

struct EpiIn0 {
    bf16_t *Q0, *K0, *V0T, *Z, *XBC; float *DT, *outK, *outV;
    __device__ __forceinline__ void operator()(const f32x4 (&acc)[2][2][4][2], int brow, int bcol, int wr, int wc, int fr, int fq) const {
        if (bcol < 512) epi_each(acc, brow, bcol, wr, wc, fr, fq, [&](int r, int c, f32x4 v, f32x4 w) { st_bf16x8(Q0 + (size_t)r * 512 + c, v * 0.125f, w * 0.125f); });
        else if (bcol < 1024) epi_each(acc, brow, bcol, wr, wc, fr, fq, [&](int r, int c, f32x4 v, f32x4 w) { c -= 512; st_bf16x8(K0 + (size_t)r * 512 + c, v, w);
            if (r < TC) { *(f32x4*)(outK + (size_t)r * 512 + c) = v; *(f32x4*)(outK + (size_t)r * 512 + c + 4) = w; } });
        else if (bcol < 1536) epi_each(acc, brow, bcol, wr, wc, fr, fq, [&](int r, int c, f32x4 v, f32x4 w) { c -= 1024; st_bf16_T(V0T, c, r, v); st_bf16_T(V0T, c + 4, r, w);
            if (r < TC) { *(f32x4*)(outV + (size_t)r * 512 + c) = v; *(f32x4*)(outV + (size_t)r * 512 + c + 4) = w; } });
        else if (bcol < 2560) epi_each(acc, brow, bcol, wr, wc, fr, fq, [&](int r, int c, f32x4 v, f32x4 w) { st_bf16x8(Z + (size_t)r * 1024 + (c - 1536), v, w); });
        else epi_each(acc, brow, bcol, wr, wc, fr, fq, [&](int r, int c, f32x4 v, f32x4 w) { st_bf16x8(XBC + (size_t)r * 1536 + (c - 2560), v, w); });
    }
};
struct EpiRes {
    const float *baseA, *baseB;
    float* XA; const float* gate;
    __device__ __forceinline__ void operator()(const f32x4 (&acc)[2][2][4][2], int brow, int bcol, int wr, int wc, int fr, int fq) const {
        const float* base = brow < TC ? baseA : baseB - (size_t)TC * 1024;
        const float* g = gate + (brow < TC ? 0 : (1 + (brow - TC) / 1024) * 6144);
        const int cb = bcol + wc * 32 + fq * 8;
        const f32x4 g00 = *(const f32x4*)(g + cb), g01 = *(const f32x4*)(g + cb + 4), g10 = *(const f32x4*)(g + cb + 128), g11 = *(const f32x4*)(g + cb + 132);
        epi_each(acc, brow, bcol, wr, wc, fr, fq, [&](int r, int c, f32x4 v, f32x4 w) {
            const f32x4 b0 = *(const f32x4*)(base + (size_t)r * 1024 + c), b1 = *(const f32x4*)(base + (size_t)r * 1024 + c + 4); const bool hi = (c - cb) != 0;
            *(f32x4*)(XA + (size_t)r * 1024 + c) = b0 + (hi ? g10 : g00) * v; *(f32x4*)(XA + (size_t)r * 1024 + c + 4) = b1 + (hi ? g11 : g01) * w; });
    }
};
struct EpiSwiglu {
    bf16_t* HID;
    __device__ __forceinline__ void operator()(const f32x4 (&acc)[2][2][4][2], int brow, int bcol, int wr, int wc, int fr, int fq) const {
        const int hc0 = (bcol >> 1) + wc * 32 + fq * 8;
#pragma unroll
        for (int ai = 0; ai < 2; ++ai)
#pragma unroll
            for (int m = 0; m < 4; ++m) {
                f32x4 o[2];
#pragma unroll
                for (int n = 0; n < 2; ++n) { const f32x4 a = acc[ai][0][m][n], b = acc[ai][1][m][n];
#pragma unroll
                    for (int j = 0; j < 4; ++j) o[n][j] = siluf(a[j]) * b[j]; }
                st_bf16x8(HID + (size_t)(brow + ai * 128 + wr * 64 + m * 16 + fr) * FFN + hc0, o[0], o[1]);
            }
    }
};
__device__ __forceinline__ f32x4 rope4(f32x4 v, int r, int c) {
    const int t = (r - TC) & 1023, grow = t >> 6, gcol = t & 63, d = c & 255, p0 = d >> 1;
    f32x4 o;
#pragma unroll
    for (int q = 0; q < 2; ++q) {
        const int p = p0 + q; const float pos = (float)(p < 64 ? grow : gcol);
        const float fr_ = exp2f(-(float)(p & 63) * (13.287712379549449f / 64.f));
        const float ang = pos * fr_; const float cs = __cosf(ang), sn = __sinf(ang);
        const float x1 = v[2 * q], x2 = v[2 * q + 1];
        o[2 * q] = x1 * cs - x2 * sn; o[2 * q + 1] = x1 * sn + x2 * cs;
    }
    return o;
}
struct EpiIn1 {
    bf16_t *QR, *KR, *KRT, *VRT, *GR;
    __device__ __forceinline__ void operator()(const f32x4 (&acc)[2][2][4][2], int brow, int bcol, int wr, int wc, int fr, int fq) const {
        const bool lat = brow >= TC;
        if (bcol < 1024) epi_each(acc, brow, bcol, wr, wc, fr, fq, [&](int r, int c, f32x4 v, f32x4 w) { if (lat) { v = rope4(v, r, c); w = rope4(w, r, c + 4); } st_bf16x8(QR + (size_t)r * 1024 + c, v, w); });
        else if (bcol < 2048) epi_each(acc, brow, bcol, wr, wc, fr, fq, [&](int r, int c, f32x4 v, f32x4 w) { c -= 1024; v = v * 0.0625f; w = w * 0.0625f; if (lat) { v = rope4(v, r, c); w = rope4(w, r, c + 4); }
            st_bf16x8(KR + (size_t)r * 1024 + c, v, w); st_bf16_T(KRT, c, r, v); st_bf16_T(KRT, c + 4, r, w); });
        else if (bcol < 4096) epi_each(acc, brow, bcol, wr, wc, fr, fq, [&](int r, int c, f32x4 v, f32x4 w) { st_bf16_T(VRT, c - 2048, r, v); st_bf16_T(VRT, c - 2048 + 4, r, w); });
        else epi_each(acc, brow, bcol, wr, wc, fr, fq, [&](int r, int c, f32x4 v, f32x4 w) { st_bf16x8(GR + (size_t)r * 2048 + (c - 4096), v, w); });
    }
};

__device__ __forceinline__ void prep_phase(const Params& p, LAS unsigned char* lds, const int part, const int bx, const int G);
template <class Epi>
__device__ __forceinline__ void gemm_phase(LAS unsigned char* lds, const bf16_t* A, const bf16_t* Bt, int N, int K, const Epi& epi, const Params* pp = nullptr, int idle_part = 0) {
    const int nM = T / BM, nN = N / BM;
    if (idle_part && (int)blockIdx.x >= nM * nN) { prep_phase(*pp, lds, idle_part, (int)blockIdx.x - nM * nN, (int)gridDim.x - nM * nN); return; }
    for (int i = 0;; ++i) { int pm, pn; if (!tile_of(i * (int)gridDim.x + (int)blockIdx.x, nM, nN, pm, pn)) break; gemm_tile(lds, A, Bt, K, pm * BM, pn * BM, epi); }
}

__device__ __forceinline__ void transpose_tile(LAS unsigned char* lds, const float* __restrict__ src, int N, int k0, int n0, bf16_t* __restrict__ dst, int drow0, int ldd) {
    LAS float* tl = (LAS float*)lds; const int tid = threadIdx.x;
#pragma unroll
    for (int i = 0; i < 2; ++i) { const int r = (tid >> 4) + 32 * i, c = (tid & 15) * 4;
        f32x4 v = (f32x4){0.f, 0.f, 0.f, 0.f}; if (n0 + c < N) v = *(const f32x4*)(src + (size_t)(k0 + r) * N + n0 + c);
        tl[r * 65 + c] = v[0]; tl[r * 65 + c + 1] = v[1]; tl[r * 65 + c + 2] = v[2]; tl[r * 65 + c + 3] = v[3]; }
    __syncthreads();
    { const int n = tid >> 3, kg = (tid & 7) * 8; float x[8];
#pragma unroll
      for (int e = 0; e < 8; ++e) x[e] = tl[(kg + e) * 65 + n];
      u32x4 w; w.x = cvt_pk_bf16(x[0], x[1]); w.y = cvt_pk_bf16(x[2], x[3]); w.z = cvt_pk_bf16(x[4], x[5]); w.w = cvt_pk_bf16(x[6], x[7]);
      *(u32x4*)(dst + (size_t)(drow0 + n) * ldd + k0 + kg) = w; }
    __syncthreads();
}
struct TJob { const float* src; bf16_t* dst; int K, N, Npad, mode; };
__device__ __forceinline__ void prep_phase(const Params& p, LAS unsigned char* lds, const int part, const int bx, const int G) {
    unsigned char* ws = p.ws; const int tid = threadIdx.x;
    const int mod_lo = part == 0 ? 0 : 96, mod_hi = part == 0 ? 96 : (part == 1 ? 192 : 96), job_lo = part == 0 ? 0 : 5, job_hi = part == 0 ? 5 : (part == 2 ? 10 : 5);
    float* MOD = (float*)(ws + O_MOD);
    if (mod_lo + bx < mod_hi) {
        LAS float* sc = (LAS float*)lds;
        LAS float* part = sc + 5 * 1024;
        for (int u = tid; u < 5 * 1024; u += NTHR) { const int ci = u >> 10, k = u & 1023; const float c = ci == 0 ? p.in[7][k] : p.in[6][(ci - 1) * 1024 + k]; sc[u] = siluf(c); }
        __syncthreads();
        for (int it = mod_lo + bx; it < mod_hi; it += G) {
            const int l = it / 96, n0 = (it % 96) * 64; const float* W = p.in[l == 0 ? 10 : 26]; const float* Bv = p.in[l == 0 ? 11 : 27];
            const int w = tid >> 6, lane = tid & 63; float a[5] = {0.f, 0.f, 0.f, 0.f, 0.f};
            for (int k = w * 128; k < w * 128 + 128; ++k) { const float wv = W[(size_t)k * 6144 + n0 + lane];
#pragma unroll
                for (int ci = 0; ci < 5; ++ci) a[ci] += sc[ci * 1024 + k] * wv; }
#pragma unroll
            for (int ci = 0; ci < 5; ++ci) part[(w * 5 + ci) * 64 + lane] = a[ci];
            __syncthreads();
            if (tid < 320) { const int ci = tid >> 6, ln = tid & 63; float s = 0.f;
#pragma unroll
                for (int w2 = 0; w2 < 8; ++w2) s += part[(w2 * 5 + ci) * 64 + ln];
                MOD[(size_t)(l * 5 + ci) * 6144 + n0 + ln] = s + Bv[n0 + ln]; }
            __syncthreads();
        }
    }
    if (part == 0) { bf16_t* CK = (bf16_t*)(ws + O_CK); const float* src = p.in[2];
      for (int u = bx * NTHR + tid; u < 4 * 256 * 512 / 4; u += G * NTHR) { const f32x4 v = *(const f32x4*)(src + (size_t)u * 4); st_bf16x4(CK + (size_t)u * 4, v); } }
    for (int j = job_lo; j < (part == 0 ? 14 : job_hi); ++j) {
        if (part == 0 && j >= 5 && j < 10) continue;
        TJob jb;
        switch (j) {
            case 0: jb = {p.in[12], (bf16_t*)(ws + O_W0IN), 1024, 4128, 4352, 0}; break;
            case 1: jb = {p.in[13], (bf16_t*)(ws + O_W0OUT), 1536, 1024, 1024, 0}; break;
            case 2: jb = {p.in[21], (bf16_t*)(ws + O_W0UP), 1024, 2816, 2816, 1}; break;
            case 3: jb = {p.in[22], (bf16_t*)(ws + O_W0UP), 1024, 2816, 2816, 2}; break;
            case 4: jb = {p.in[23], (bf16_t*)(ws + O_W0DN), 2816, 1024, 1024, 0}; break;
            case 5: jb = {p.in[28], (bf16_t*)(ws + O_W1IN), 1024, 6144, 6144, 0}; break;
            case 6: jb = {p.in[29], (bf16_t*)(ws + O_W1OUT), 2048, 1024, 1024, 0}; break;
            case 7: jb = {p.in[32], (bf16_t*)(ws + O_W1UP), 1024, 2816, 2816, 1}; break;
            case 8: jb = {p.in[33], (bf16_t*)(ws + O_W1UP), 1024, 2816, 2816, 2}; break;
            case 9: jb = {p.in[34], (bf16_t*)(ws + O_W1DN), 2816, 1024, 1024, 0}; break;
            default: jb = {p.in[3] + (size_t)(j - 10) * 256 * 512, (bf16_t*)(ws + O_CVT) + (size_t)(j - 10) * 512 * 256, 256, 512, 512, 0}; break;
        }
        const int nkt = jb.K / 64, nnt = jb.Npad / 64, ntile = nkt * nnt;
        for (int tix = (bx + 64 * j) % G; tix < ntile; tix += G) {
            const int kt = tix % nkt, ntl = tix / nkt, n0 = ntl * 64;
            int drow0 = n0; if (jb.mode) drow0 = (n0 / 128) * 256 + (n0 % 128) + (jb.mode == 2 ? 128 : 0);
            transpose_tile(lds, jb.src, jb.N, kt * 64, n0, jb.dst, drow0, jb.K);
        }
    }
}

__device__ __forceinline__ void norm_phase(const float* xa, const float* xb, const float* nw, const float* mod  , int sh_off, int sc_off, bf16_t* H, float* outf) {
    const int lane = threadIdx.x & 63, gw = blockIdx.x * 8 + (threadIdx.x >> 6), nw_tot = gridDim.x * 8;
    for (int r0 = gw; r0 < T; r0 += 2 * nw_tot) {
        const int r1 = r0 + nw_tot < T ? r0 + nw_tot : r0;
        f32x4 v[2][4]; float ss[2];
#pragma unroll
        for (int u = 0; u < 2; ++u) { const int r = u ? r1 : r0; const float* x = r < TC ? xa + (size_t)r * 1024 : xb + (size_t)(r - TC) * 1024; ss[u] = 0.f;
#pragma unroll
            for (int q = 0; q < 4; ++q) { v[u][q] = *(const f32x4*)(x + (q >> 1) * 512 + lane * 8 + (q & 1) * 4); ss[u] += v[u][q][0] * v[u][q][0] + v[u][q][1] * v[u][q][1] + v[u][q][2] * v[u][q][2] + v[u][q][3] * v[u][q][3]; } }
#pragma unroll
        for (int u = 0; u < 2; ++u) {
            const int r = u ? r1 : r0; if (u && r1 == r0) break;
            const float rstd = rsqrtf(wave_sum(ss[u]) * (1.f / 1024.f) + 1e-6f);
            if (outf) {
#pragma unroll
                for (int q = 0; q < 4; ++q) { const int c = (q >> 1) * 512 + lane * 8 + (q & 1) * 4; const f32x4 w = *(const f32x4*)(nw + c); *(f32x4*)(outf + (size_t)r * 1024 + c) = v[u][q] * rstd * w; }
            } else {
                const float* md = mod + (r < TC ? 0 : (1 + (r - TC) / 1024) * 6144);
#pragma unroll
                for (int h2 = 0; h2 < 2; ++h2) { const int c = h2 * 512 + lane * 8; f32x4 o[2];
#pragma unroll
                    for (int e = 0; e < 2; ++e) { const f32x4 w = *(const f32x4*)(nw + c + 4 * e), sc = *(const f32x4*)(md + sc_off + c + 4 * e), sh = *(const f32x4*)(md + sh_off + c + 4 * e);
                        o[e] = v[u][h2 * 2 + e] * rstd * w * (sc + 1.f) + sh; }
                    st_bf16x8(H + (size_t)r * 1024 + c, o[0], o[1]); }
            }
        }
    }
}

__device__ __forceinline__ void conv_phase(const Params& p, LAS unsigned char* lds) {
    unsigned char* ws = p.ws; const bf16_t* XBC = (const bf16_t*)(ws + O_XBC); bf16_t* XC = (bf16_t*)(ws + O_XC); bf16_t* XT = (bf16_t*)(ws + O_XT);
    const float* cw = p.in[15]; const float* cb = p.in[16];
    const int tid = threadIdx.x; LAS bf16_t* tl = (LAS bf16_t*)lds;
    for (int it = blockIdx.x; it < 96 * 24; it += gridDim.x) {
        const int tt = it / 24, ct = it % 24, tok0 = tt * 128, c0 = ct * 64;
        const int L = tok0 < TC ? 256 : 1024, ts0 = tok0 < TC ? (tok0 & 255) : ((tok0 - TC) & 1023);
        const int tp = (tid >> 3) * 2, cg_ = (tid & 7) * 8, tok = tok0 + tp, ts = ts0 + tp, ch = c0 + cg_;
        u32x4 rw[6];
#pragma unroll
        for (int k = 0; k < 6; ++k) { const int tsk = ts + k - 2; rw[k] = (u32x4){0u, 0u, 0u, 0u}; if (tsk >= 0 && tsk < L) rw[k] = *(const u32x4*)(XBC + (size_t)(tok + k - 2) * 1536 + ch); }
        float a0[8], a1[8];
        { const f32x4 b0 = *(const f32x4*)(cb + ch), b1 = *(const f32x4*)(cb + ch + 4);
#pragma unroll
          for (int e = 0; e < 4; ++e) { a0[e] = b0[e]; a0[e + 4] = b1[e]; a1[e] = b0[e]; a1[e + 4] = b1[e]; } }
#pragma unroll
        for (int k = 0; k < 5; ++k) { const f32x4 w0 = *(const f32x4*)(cw + k * 1536 + ch), w1 = *(const f32x4*)(cw + k * 1536 + ch + 4);
            float x0[8], x1[8]; unpack8(rw[k], x0); unpack8(rw[k + 1], x1);
#pragma unroll
            for (int e = 0; e < 8; ++e) { const float wv = e < 4 ? w0[e] : w1[e - 4]; a0[e] += wv * x0[e]; a1[e] += wv * x1[e]; } }
#pragma unroll
        for (int e = 0; e < 8; ++e) { a0[e] = siluf(a0[e]); a1[e] = siluf(a1[e]); }
        u32x4 o0, o1; o0.x = cvt_pk_bf16(a0[0], a0[1]); o0.y = cvt_pk_bf16(a0[2], a0[3]); o0.z = cvt_pk_bf16(a0[4], a0[5]); o0.w = cvt_pk_bf16(a0[6], a0[7]);
        o1.x = cvt_pk_bf16(a1[0], a1[1]); o1.y = cvt_pk_bf16(a1[2], a1[3]); o1.z = cvt_pk_bf16(a1[4], a1[5]); o1.w = cvt_pk_bf16(a1[6], a1[7]);
        *(u32x4*)(XC + (size_t)tok * 1536 + ch) = o0; *(u32x4*)(XC + (size_t)(tok + 1) * 1536 + ch) = o1;
        if (ct < 20) {
#pragma unroll
            for (int e = 0; e < 8; ++e) *(LAS unsigned*)(tl + (cg_ + e) * 136 + tp) = cvt_pk_bf16(a0[e], a1[e]);
            __syncthreads();
#pragma unroll
            for (int q = 0; q < 2; ++q) { const int pid = q * NTHR + tid, chl = pid >> 4, tg = (pid & 15) * 8;
                const u32x4 w = *(const LAS u32x4*)(tl + chl * 136 + tg);
                *(u32x4*)(XT + (size_t)(c0 + chl) * T + tok0 + tg) = w; }
            __syncthreads();
        }
    }
}

struct NaState { float m, l; f32x4 o[4]; };
struct NaChunk { const bf16_t* kb; const bf16_t* vtb; size_t ldv; const LAS float* biasrow; int kc0; bool local; int tile;   };
__device__ __forceinline__ void na_load(const NaChunk& ch, int fr, int fq, bf16x8 (&kf)[2][2], u32x4 (&vw)[4]) {
#pragma unroll
    for (int t = 0; t < 2; ++t)
#pragma unroll
        for (int ks = 0; ks < 2; ++ks) kf[t][ks] = *(const bf16x8*)(ch.kb + (size_t)(16 * t + fr) * 512 + ks * 32 + fq * 8);
#pragma unroll
    for (int dt = 0; dt < 4; ++dt) { const bf16_t* vp = ch.vtb + (size_t)(dt * 16 + fr) * ch.ldv + 4 * fq;
        const u32x2 lo = *(const u32x2*)vp, hi = *(const u32x2*)(vp + 16); vw[dt].x = lo.x; vw[dt].y = lo.y; vw[dt].z = hi.x; vw[dt].w = hi.y; }
}
__device__ __forceinline__ void na_compute(NaState& st, const bf16x8 (&qf)[2], const bf16x8 (&kf)[2][2], const u32x4 (&vw)[4], const NaChunk& ch, int fq, int qc) {
    f32x4 s[2];
#pragma unroll
    for (int t = 0; t < 2; ++t) { s[t] = (f32x4){0.f, 0.f, 0.f, 0.f};
#pragma unroll
        for (int ks = 0; ks < 2; ++ks) s[t] = mfma16(kf[t][ks], qf[ks], s[t]); }
    if (ch.local) {
        const int c0 = min(max(qc - 8, 0), 48);
#pragma unroll
        for (int t = 0; t < 2; ++t)
#pragma unroll
            for (int j = 0; j < 4; ++j) { const int kc = ch.kc0 + 16 * t + 4 * fq + j; const bool ok = kc >= c0 && kc < c0 + 16; const int dc = min(max(kc - qc + 15, 0), 30);
                s[t][j] = ok ? s[t][j] + ch.biasrow[dc] : -INFINITY; }
    }
    float mx = fmaxf(fmaxf(fmaxf(s[0][0], s[0][1]), fmaxf(s[0][2], s[0][3])), fmaxf(fmaxf(s[1][0], s[1][1]), fmaxf(s[1][2], s[1][3])));
    mx = fmaxf(mx, __shfl_xor(mx, 16)); mx = fmaxf(mx, __shfl_xor(mx, 32));
    const float mn = fmaxf(st.m, mx), alpha = __expf(st.m - mn); st.m = mn;
    float ps = 0.f;
#pragma unroll
    for (int t = 0; t < 2; ++t)
#pragma unroll
        for (int j = 0; j < 4; ++j) { s[t][j] = __expf(s[t][j] - mn); ps += s[t][j]; }
    st.l = st.l * alpha + ps;
    u32x4 pw; pw.x = cvt_pk_bf16(s[0][0], s[0][1]); pw.y = cvt_pk_bf16(s[0][2], s[0][3]); pw.z = cvt_pk_bf16(s[1][0], s[1][1]); pw.w = cvt_pk_bf16(s[1][2], s[1][3]);
    const bf16x8 pf = as_bf16x8(pw);
#pragma unroll
    for (int dt = 0; dt < 4; ++dt) st.o[dt] = mfma16(as_bf16x8(vw[dt]), pf, st.o[dt] * alpha);
}
__device__ __forceinline__ void na_phase(const Params& p, LAS unsigned char* lds) {
    unsigned char* ws = p.ws; const bf16_t* Q0 = (const bf16_t*)(ws + O_Q0); const bf16_t* K0 = (const bf16_t*)(ws + O_K0); const bf16_t* V0T = (const bf16_t*)(ws + O_V0T);
    const bf16_t* CK = (const bf16_t*)(ws + O_CK); const bf16_t* CVT = (const bf16_t*)(ws + O_CVT); bf16_t* MIX = (bf16_t*)(ws + O_MIX); const float* nb = p.in[14];
    const int lane = threadIdx.x & 63, fr = lane & 15, fq = lane >> 4, gw = blockIdx.x * 8 + (threadIdx.x >> 6), nwv = gridDim.x * 8;
    LAS float* lnb = (LAS float*)(lds + 20480);
    for (int u = threadIdx.x; u < 8 * 465; u += NTHR) lnb[u] = nb[u];
    constexpr int WOFF = 40960, WRS = 2064;
    const bool has_dt = (int)blockIdx.x * 8 + 7 >= 1024 && (int)blockIdx.x * 8 - 1024 < T / 16;
    if (has_dt) { const bf16_t* W = (const bf16_t*)(ws + O_W0IN) + (size_t)4096 * 1024;
#pragma unroll
        for (int q = 0; q < 8; ++q) { const int pid = q * NTHR + threadIdx.x, row = pid >> 7, c8 = pid & 127; *(LAS u32x4*)(lds + WOFF + row * WRS + c8 * 16) = *(const u32x4*)(W + (size_t)row * 1024 + c8 * 8); } }
    __syncthreads();
    { const bf16_t* H = (const bf16_t*)(ws + O_H); float* DT = (float*)(ws + O_DT);
      LAS unsigned char* const wb = opq(lds + WOFF + fr * WRS + fq * 16);
      for (int it = gw - 1024; it >= 0 && it < T / 16; it += nwv) {
          f32x4 d0 = (f32x4){0.f, 0.f, 0.f, 0.f}, d1 = d0;
#pragma unroll
          for (int kb = 0; kb < 4; ++kb) {
              bf16x8 hf[8]; __builtin_amdgcn_sched_barrier(0);
#pragma unroll
              for (int ks = 0; ks < 8; ++ks) hf[ks] = *(const bf16x8*)(H + (size_t)(it * 16 + fr) * 1024 + (kb * 8 + ks) * 32 + fq * 8);
#pragma unroll
              for (int ks = 0; ks < 8; ++ks) { const int k = kb * 8 + ks;
                  const bf16x8 w0 = *(const LAS bf16x8*)(wb + k * 64), w1 = *(const LAS bf16x8*)(wb + 16 * WRS + k * 64);
                  d0 = mfma16(w0, hf[ks], d0); d1 = mfma16(w1, hf[ks], d1); } }
          *(f32x4*)(DT + (size_t)(it * 16 + fr) * 32 + 4 * fq) = d0; *(f32x4*)(DT + (size_t)(it * 16 + fr) * 32 + 16 + 4 * fq) = d1; } }
    const int bx = blockIdx.x, wv = threadIdx.x >> 6;
    for (int k = 0; k < 2; ++k) {
        int it;
        if (gridDim.x != 256) { it = gw * 2 + k; if (gw * 2 + k >= 3072) break; if (gw >= 512 && k == 0) { } it = (gw < 1024) ? (k ? -1 : gw) : 1024 + 2 * (gw - 1024) + k; if (it < 0) break; }
        else if (bx < 128) { if (k) break; const int q = (bx >> 3) * 8 + wv; it = ((q >> 5) << 8) | ((bx & 7) << 5) | (q & 31); }
        else { const int j = bx - 128, x = j & 7, idx = (j >> 3) * 16 + wv * 2 + k; it = 1024 + (((4 * x + (idx >> 6)) << 6) | (idx & 63)); }
        if (it >= 1024 + 2048) break;
        NaState st[2];
#pragma unroll
        for (int u = 0; u < 2; ++u) { st[u].m = -INFINITY; st[u].l = 0.f;
#pragma unroll
            for (int d = 0; d < 4; ++d) st[u].o[d] = (f32x4){0.f, 0.f, 0.f, 0.f}; }
        bf16x8 qf[2][2]; int qtok0, h, b, r = 0, qc0 = 0, NC = 8; const bool lat = it < 1024;
        if (lat) { b = it >> 8; h = (it >> 5) & 7; r = (it >> 1) & 15; qc0 = (it & 1) * 32; qtok0 = TC + b * 1024 + r * 64 + qc0 + fr; NC = 24; }
        else { const int u = it - 1024; b = u >> 6; h = (u >> 3) & 7; qtok0 = b * 256 + (u & 7) * 32 + fr; }
        const int r0 = min(max(r - 4, 0), 8);
#pragma unroll
        for (int u = 0; u < 2; ++u)
#pragma unroll
            for (int ks = 0; ks < 2; ++ks) qf[u][ks] = *(const bf16x8*)(Q0 + (size_t)(qtok0 + 16 * u) * 512 + h * 64 + ks * 32 + fq * 8);
        auto get = [&](int c) { NaChunk ch; ch.biasrow = lnb; ch.kc0 = 0; ch.local = false; ch.tile = -1;
            if (!lat) { const int ktok = b * 256 + c * 32; ch.kb = K0 + (size_t)ktok * 512 + h * 64; ch.vtb = V0T + (size_t)(h * 64) * T + ktok; ch.ldv = T; }
            else if (c < 8) { ch.kb = CK + (size_t)(b * 256 + c * 32) * 512 + h * 64; ch.vtb = CVT + (size_t)(b * 512 + h * 64) * 256 + c * 32; ch.ldv = 256; }
            else {
                const int l = c - 8, s_ = l >> 1, u = l & 1, br = r0 + s_, ct = qc0 + 16 * u, kc0 = min(min(max(ct - 8, 0), 48), 32), ktok = TC + b * 1024 + br * 64 + kc0;
                ch.kb = K0 + (size_t)ktok * 512 + h * 64; ch.vtb = V0T + (size_t)(h * 64) * T + ktok; ch.ldv = T; ch.biasrow = lnb + h * 465 + (br - r + 7) * 31; ch.kc0 = kc0; ch.local = true; ch.tile = u; }
            return ch; };
        bf16x8 kfa[2][2], kfb[2][2], kfc[2][2]; u32x4 vwa[4], vwb[4], vwc[4];
        { const NaChunk c0_ = get(0), c1_ = get(1); na_load(c0_, fr, fq, kfa, vwa); na_load(c1_, fr, fq, kfb, vwb); }
        auto step = [&](const bf16x8 (&kfx)[2][2], const u32x4 (&vwx)[4], bf16x8 (&kfy)[2][2], u32x4 (&vwy)[4], int c) {
            if (c + 2 < NC) { const NaChunk n2 = get(c + 2); na_load(n2, fr, fq, kfy, vwy); }
            const NaChunk cur = get(c);
            if (cur.tile != 1) na_compute(st[0], qf[0], kfx, vwx, cur, fq, qc0 + fr);
            if (cur.tile != 0) na_compute(st[1], qf[1], kfx, vwx, cur, fq, qc0 + 16 + fr);
        };
        for (int c = 0; c < NC; c += 3) {
            step(kfa, vwa, kfc, vwc, c);
            if (c + 1 < NC) step(kfb, vwb, kfa, vwa, c + 1);
            if (c + 2 < NC) step(kfc, vwc, kfb, vwb, c + 2);
        }
#pragma unroll
        for (int u = 0; u < 2; ++u) { float l = st[u].l; l += __shfl_xor(l, 16); l += __shfl_xor(l, 32); const float inv = 1.f / l;
#pragma unroll
            for (int dt = 0; dt < 4; ++dt) st_bf16x4(MIX + (size_t)(qtok0 + 16 * u) * 1536 + h * 64 + dt * 16 + 4 * fq, st[u].o[dt] * inv); }
    }
}

template <int DK, bool SSD, int DV, bool GPRE>
__device__ __forceinline__ void scan_item(LAS unsigned char* lds, const bf16_t* Qg, const bf16_t* Kg, int ldqk, const bf16_t* KTg, const bf16_t* VTg, int tok0, int nch, int dir,
                          const float* s0, float* sfin, int ldS, bf16_t* Y, int ldy, const float* DTp, float dtb, float aneg, const float* GPh  ) {
    constexpr int NKS = DK / 32, RS = DK * 2 + 16, TS = 144, NPT = DV / 16, NPW = NPT / 2  , NPI = NPT / 4  ;
    constexpr int OQ = 1024, OK_ = OQ + 64 * RS, OKT = GPRE ? OK_ : OK_ + 64 * RS, OVT = OKT + DK * TS, OS = OVT + DV * TS;
    static_assert(OS + DV * RS <= LDS_XB_OFF, "scan LDS budget");
    constexpr int NPQ = 64 * DK / 8 / NTHR, NPKT = DK * 8 / NTHR, NPV = DV * 8 / NTHR, C8 = DK / 8, NPK = GPRE ? 0 : NPQ;
    LAS float* le = (LAS float*)lds; LAS float* ldtv = le + 64; LAS float* ldtt = le + 128; LAS float* lE = le + 192;
    const int tid = threadIdx.x, wid = __builtin_amdgcn_readfirstlane(tid >> 6), lane = tid & 63, fr = lane & 15, fq = lane >> 4;
    const int it = wid & 3, ph = wid >> 2, i = it * 16 + fr;
    constexpr int RPQ = NTHR / C8;
    LAS unsigned char* const qb = opq(lds + OQ + i * RS + fq * 16);
    LAS unsigned char* const kb_ = opq(lds + OK_ + fr * RS + fq * 16);
    LAS unsigned char* const zb = opq(lds + OS + (NPW * ph * 16 + fr) * RS + fq * 16);
    LAS unsigned char* const ktb = opq(lds + OKT + (ph * NKS * 16 + fr) * TS + fq * 16);
    LAS unsigned char* const vyb = opq(lds + OVT + (NPW * ph * 16 + fr) * TS + fq * 8);
    LAS unsigned char* const vsb = opq(lds + OVT + (it * 16 + fr) * TS + fq * 16);
    LAS unsigned char* const stb = opq(lds + OS + (it * 16 + 4 * fq) * RS + (ph * NKS * 16 + fr) * 2);
    LAS unsigned char* const cqb = opq(lds + OQ + (tid / C8) * RS + (tid % C8) * 16);
    LAS unsigned char* const ckb = opq(lds + OK_ + (tid / C8) * RS + (tid % C8) * 16);
    LAS unsigned char* const cktb = opq(lds + OKT + (tid >> 3) * TS + (tid & 7) * 16);
    LAS unsigned char* const cvb = opq(lds + OVT + (tid >> 3) * TS + (tid & 7) * 16);
    u32x4 pf[NPQ + NPK + NPKT + NPV]; f32x4 gcur[4];
    auto issue = [&](int tokc) {
        int t_ = tid; asm volatile("" : "+v"(t_));
#pragma unroll
        for (int q = 0; q < NPQ; ++q) { const int pid = q * NTHR + t_, row = pid / C8, c8 = pid % C8;
            pf[q] = *(const u32x4*)(Qg + (size_t)(tokc + row) * ldqk + c8 * 8); if (!GPRE) pf[NPQ + q] = *(const u32x4*)(Kg + (size_t)(tokc + row) * ldqk + c8 * 8); }
#pragma unroll
        for (int q = 0; q < NPKT; ++q) { const int pid = q * NTHR + t_, n = pid >> 3, tg = pid & 7; pf[NPQ + NPK + q] = *(const u32x4*)(KTg + (size_t)n * T + tokc + tg * 8); }
#pragma unroll
        for (int q = 0; q < NPV; ++q) { const int pid = q * NTHR + t_, pr = pid >> 3, tg = pid & 7; pf[NPQ + NPK + NPKT + q] = *(const u32x4*)(VTg + (size_t)pr * T + tokc + tg * 8); }
    };
    auto issue_g = [&](int tokc) {
#pragma unroll
        for (int jt = 0; jt < 4; ++jt) if (dir ? (jt >= it) : (jt <= it)) gcur[jt] = *(const f32x4*)(GPh + ((size_t)((tokc >> 6) * 4 * 16 + it * 4 + jt) * 64 + lane) * 4);
    };
    auto commit = [&]() {
#pragma unroll
        for (int q = 0; q < NPQ; ++q) { *(LAS u32x4*)(cqb + q * RPQ * RS) = pf[q]; if (!GPRE) *(LAS u32x4*)(ckb + q * RPQ * RS) = pf[NPQ + q]; }
#pragma unroll
        for (int q = 0; q < NPKT; ++q) *(LAS u32x4*)(cktb + q * 64 * TS) = pf[NPQ + NPK + q];
#pragma unroll
        for (int q = 0; q < NPV; ++q) *(LAS u32x4*)(cvb + q * 64 * TS) = pf[NPQ + NPK + NPKT + q];
    };
    const bool oddl = fr & 1;
    LAS unsigned char* const stb2 = opq(stb + (oddl ? 2 * RS - 2 : 0));
    auto put_state = [&](const f32x4 (&sacc)[NPI][NKS]) {
#pragma unroll
        for (int pi = 0; pi < NPI; ++pi)
#pragma unroll
            for (int q = 0; q < NKS; ++q) { const f32x4 a = sacc[pi][q];
                const float s0_ = oddl ? a[0] : a[2], s1_ = oddl ? a[1] : a[3];
                const float r0_ = __int_as_float(__builtin_amdgcn_update_dpp(0, __float_as_int(s0_), 0xB1, 0xF, 0xF, true));
                const float r1_ = __int_as_float(__builtin_amdgcn_update_dpp(0, __float_as_int(s1_), 0xB1, 0xF, 0xF, true));
                const unsigned w0 = oddl ? cvt_pk_bf16(r0_, a[2]) : cvt_pk_bf16(a[0], r0_), w1 = oddl ? cvt_pk_bf16(r1_, a[3]) : cvt_pk_bf16(a[1], r1_);
                *(LAS unsigned*)(stb2 + (pi * 64) * RS + q * 32) = w0; *(LAS unsigned*)(stb2 + (pi * 64 + 1) * RS + q * 32) = w1; }
    };
    issue(tok0 + (dir ? nch - 1 : 0) * 64);
    float dtraw = 0.f;
    if (SSD && wid == 0) dtraw = DTp[(size_t)(tok0 + (dir ? nch - 1 : 0) * 64 + lane) * 32];
    f32x4 sacc[NPI][NKS];
#pragma unroll
    for (int pi = 0; pi < NPI; ++pi)
#pragma unroll
        for (int q = 0; q < NKS; ++q) { const int nt = ph * NKS + q, ptl = it + 4 * pi;
            sacc[pi][q] = s0 ? *(const f32x4*)(s0 + (size_t)(nt * 16 + fr) * ldS + ptl * 16 + 4 * fq) : (f32x4){0.f, 0.f, 0.f, 0.f}; }
    put_state(sacc);
#pragma unroll
    for (int jt = 0; jt < 4; ++jt) gcur[jt] = (f32x4){0.f, 0.f, 0.f, 0.f};
    if (GPRE) issue_g(tok0 + (dir ? nch - 1 : 0) * 64);
    commit();
    for (int cc = 0; cc < nch; ++cc) {
        const int c = dir ? nch - 1 - cc : cc, tokc = tok0 + c * 64;
        const bool has_next = cc + 1 < nch; const int tokn = tok0 + (dir ? c - 1 : c + 1) * 64;
        if (!GPRE && has_next) issue(tokn);
        if (wid == 0) {
            float dt = 1.f, a = aneg;
            if (SSD) { dt = softplusf(dtraw + dtb); a = dt * aneg; if (has_next) dtraw = DTp[(size_t)(tokn + lane) * 32]; }
            float cs = a;
#pragma unroll
            for (int o = 1; o < 64; o <<= 1) { const float v = __shfl_up(cs, o); if (lane >= o) cs += v; }
            const float tot = __shfl(cs, 63), e = dir ? (tot - cs + a) : cs;
            le[lane] = e; ldtv[lane] = dt; ldtt[lane] = dt * __expf(tot - e); if (lane == 0) lE[0] = tot;
        }
        __syncthreads();
        const float ei = le[i];
        bf16x8 qf[NKS];
        if (!GPRE) {
#pragma unroll
            for (int ks = 0; ks < NKS; ++ks) qf[ks] = *(const LAS bf16x8*)(qb + ks * 64);
        }
        unsigned pw[2][4];
#pragma unroll
        for (int jt = 0; jt < 4; ++jt) {
            const bool tv = dir ? (jt >= it) : (jt <= it);
            f32x4 g = (f32x4){0.f, 0.f, 0.f, 0.f};
            if (tv) {
                if (GPRE) g = gcur[jt];
                else {
#pragma unroll
                    for (int ks = 0; ks < NKS; ++ks) { const bf16x8 kf = *(const LAS bf16x8*)(kb_ + jt * 16 * RS + ks * 64); g = mfma16(kf, qf[ks], g); }
                }
                const f32x4 ej = *(const LAS f32x4*)(le + jt * 16 + 4 * fq);
#pragma unroll
                for (int j = 0; j < 4; ++j) { const int jj = jt * 16 + 4 * fq + j; const bool ok = dir ? (jj >= i) : (jj <= i); g[j] = ok ? g[j] * __expf(ei - ej[j]) : 0.f; }
            }
            pw[jt >> 1][(jt & 1) * 2] = cvt_pk_bf16(g[0], g[1]); pw[jt >> 1][(jt & 1) * 2 + 1] = cvt_pk_bf16(g[2], g[3]);
        }
        if (GPRE && has_next) { issue_g(tokn); issue(tokn); }
        const float ex = __expf(ei);
        f32x4 ya[NPW], za[NPW];
#pragma unroll
        for (int pp = 0; pp < NPW; ++pp) {
            const int pt = NPW * ph + pp; ya[pp] = (f32x4){0.f, 0.f, 0.f, 0.f}; za[pp] = (f32x4){0.f, 0.f, 0.f, 0.f};
#pragma unroll
            for (int k2 = 0; k2 < 2; ++k2) {
                const bool skip = dir ? (2 * k2 + 1 < it) : (2 * k2 > it);
                if (!skip) {
                    const LAS unsigned char* vp = vyb + pp * 16 * TS + k2 * 64;
                    u32x2 lo = *(const LAS u32x2*)vp, hi = *(const LAS u32x2*)(vp + 32);
                    if (SSD) { const int j0 = 32 * k2 + 4 * fq; const f32x4 d0 = *(const LAS f32x4*)(ldtv + j0), d1 = *(const LAS f32x4*)(ldtv + j0 + 16);
                        lo.x = cvt_pk_bf16(bf_lo(lo.x) * d0[0], bf_hi(lo.x) * d0[1]); lo.y = cvt_pk_bf16(bf_lo(lo.y) * d0[2], bf_hi(lo.y) * d0[3]);
                        hi.x = cvt_pk_bf16(bf_lo(hi.x) * d1[0], bf_hi(hi.x) * d1[1]); hi.y = cvt_pk_bf16(bf_lo(hi.y) * d1[2], bf_hi(hi.y) * d1[3]); }
                    u32x4 vw; vw.x = lo.x; vw.y = lo.y; vw.z = hi.x; vw.w = hi.y;
                    u32x4 pfr; pfr.x = pw[k2][0]; pfr.y = pw[k2][1]; pfr.z = pw[k2][2]; pfr.w = pw[k2][3];
                    ya[pp] = mfma16(as_bf16x8(vw), as_bf16x8(pfr), ya[pp]);
                }
            }
        }
#pragma unroll
        for (int ks = 0; ks < NKS; ++ks) {
            const bf16x8 qk = GPRE ? *(const LAS bf16x8*)(qb + ks * 64) : qf[ks];
#pragma unroll
            for (int pp = 0; pp < NPW; ++pp) { const bf16x8 sf = *(const LAS bf16x8*)(zb + pp * 16 * RS + ks * 64); za[pp] = mfma16(sf, qk, za[pp]); }
        }
#pragma unroll
        for (int pp = 0; pp < NPW; ++pp) st_bf16x4(Y + (size_t)(tokc + i) * ldy + (NPW * ph + pp) * 16 + 4 * fq, ya[pp] + za[pp] * ex);
        {
            const float eE = __expf(lE[0]);
            bf16x8 vs[NPI][2];
#pragma unroll
            for (int pi = 0; pi < NPI; ++pi)
#pragma unroll
                for (int k2 = 0; k2 < 2; ++k2) { const u32x4 w = *(const LAS u32x4*)(vsb + pi * 64 * TS + k2 * 64); const int j0 = k2 * 32 + fq * 8;
                    const f32x4 t0 = *(const LAS f32x4*)(ldtt + j0), t1 = *(const LAS f32x4*)(ldtt + j0 + 4); u32x4 o;
                    o.x = cvt_pk_bf16(bf_lo(w.x) * t0[0], bf_hi(w.x) * t0[1]); o.y = cvt_pk_bf16(bf_lo(w.y) * t0[2], bf_hi(w.y) * t0[3]);
                    o.z = cvt_pk_bf16(bf_lo(w.z) * t1[0], bf_hi(w.z) * t1[1]); o.w = cvt_pk_bf16(bf_lo(w.w) * t1[2], bf_hi(w.w) * t1[3]);
                    vs[pi][k2] = as_bf16x8(o); }
#pragma unroll
            for (int q = 0; q < NKS; ++q) { const int nt = ph * NKS + q;
                bf16x8 kt[2];
#pragma unroll
                for (int k2 = 0; k2 < 2; ++k2) kt[k2] = *(const LAS bf16x8*)(ktb + q * 16 * TS + k2 * 64);
#pragma unroll
                for (int pi = 0; pi < NPI; ++pi) { sacc[pi][q] = sacc[pi][q] * eE;
#pragma unroll
                    for (int k2 = 0; k2 < 2; ++k2) sacc[pi][q] = mfma16(vs[pi][k2], kt[k2], sacc[pi][q]); }
                if (GPRE && (q & 1)) __builtin_amdgcn_sched_barrier(0);
            }
        }
        __syncthreads();
        if (has_next) {
            put_state(sacc);
            commit();
        }
    }
    if (sfin) {
#pragma unroll
        for (int pi = 0; pi < NPI; ++pi)
#pragma unroll
            for (int q = 0; q < NKS; ++q) { const int nt = ph * NKS + q; *(f32x4*)(sfin + (size_t)(nt * 16 + fr) * ldS + (it + 4 * pi) * 16 + 4 * fq) = sacc[pi][q]; }
    }
}
__device__ __forceinline__ void retg_item(const bf16_t* QR, const bf16_t* KR, float* GP, int c, int h, int it, int lane) {
    const int fr = lane & 15, fq = lane >> 4, tokc = c * 64;
    bf16x8 qf[8];
#pragma unroll
    for (int ks = 0; ks < 8; ++ks) qf[ks] = *(const bf16x8*)(QR + (size_t)(tokc + it * 16 + fr) * 1024 + h * 256 + ks * 32 + fq * 8);
#pragma unroll
    for (int jt = 0; jt < 4; ++jt) { f32x4 g = (f32x4){0.f, 0.f, 0.f, 0.f};
#pragma unroll
        for (int ks = 0; ks < 8; ++ks) { const bf16x8 kf = *(const bf16x8*)(KR + (size_t)(tokc + jt * 16 + fr) * 1024 + h * 256 + ks * 32 + fq * 8); g = mfma16(kf, qf[ks], g); }
        *(f32x4*)(GP + ((size_t)(((c * 4 + h) * 4 + it) * 4 + jt) * 64 + lane) * 4) = g; }
}
__device__ __forceinline__ void in1_phase(const Params& p, LAS unsigned char* lds, const EpiIn1& e) {
    unsigned char* ws = p.ws; const bf16_t* H = (const bf16_t*)(ws + O_H); const bf16_t* W = (const bf16_t*)(ws + O_W1IN);
    const int bx = (int)blockIdx.x, G = (int)gridDim.x; const bool fused = G == 256;
    for (int k = 0;; ++k) {
        int pm, pn; bool ok;
        if (fused) { ok = k < 3;
            if (bx < 192) { pm = bx >> 2; pn = 4 * k + (bx & 3); }
            else { const int t = (bx - 192) * 3 + k; pm = t >> 2; pn = 12 + (t & 3); } }
        else ok = tile_of(k * G + bx, T / BM, 16, pm, pn);
        if (!ok) break;
        gemm_tile(lds, H, W, 1024, pm * BM, pn * BM, e);
        if (fused && bx < 192 && k == 1) {
            const bf16_t* QR = (const bf16_t*)(ws + O_QR); const bf16_t* KR = (const bf16_t*)(ws + O_KR); float* GP = (float*)(ws + O_GP);
            const int wv = threadIdx.x >> 6, lane = threadIdx.x & 63;
            for (int u = wv; u < 16; u += 8) retg_item(QR, KR, GP, pm * 4 + (u >> 2), bx & 3, u & 3, lane);
        }
    }
}
__device__ __forceinline__ void retg_phase(const Params& p) {
    unsigned char* ws = p.ws; const bf16_t* QR = (const bf16_t*)(ws + O_QR); const bf16_t* KR = (const bf16_t*)(ws + O_KR); float* GP = (float*)(ws + O_GP);
    const int lane = threadIdx.x & 63, gw = blockIdx.x * 8 + (threadIdx.x >> 6), nwv = gridDim.x * 8;
    for (int idx = gw; idx < 192 * 4 * 4; idx += nwv) retg_item(QR, KR, GP, idx >> 4, (idx >> 2) & 3, idx & 3, lane);
}
__device__ __forceinline__ int next_item(unsigned* ctr, LAS unsigned char* lds) {
    LAS int* slot = (LAS int*)(lds + 896);
    if (threadIdx.x == 0) slot[0] = (int)atomicAdd(ctr, 1u);
    __syncthreads();
    const int v = slot[0];
    __syncthreads();
    return v;
}
__device__ __forceinline__ void ssd_phase(const Params& p, LAS unsigned char* lds, int rep) {
    unsigned char* ws = p.ws; unsigned* ctr = (unsigned*)(ws + O_CTL) + 0 + 2 * rep;
    const bf16_t* XC = (const bf16_t*)(ws + O_XC); const bf16_t* XT = (const bf16_t*)(ws + O_XT); bf16_t* YS = (bf16_t*)(ws + O_YS); const float* DT = (const float*)(ws + O_DT);
    for (;;) {
        const int it = next_item(ctr, lds); if (it >= 128 + 1024) break;
        int b, dir, h, tok0, nch; const float* s0 = nullptr; float* sfin = nullptr;
        if (it < 128) { b = it >> 5; dir = (it >> 4) & 1; h = it & 15; tok0 = TC + b * 1024; nch = 16; s0 = p.in[4] + (size_t)((b * 2 + dir) * 16 + h) * 128 * 64; }
        else { const int u = it - 128; b = u >> 5; dir = (u >> 4) & 1; h = u & 15; tok0 = b * 256; nch = 4; sfin = p.out + OUT_SSD + (size_t)((b * 2 + dir) * 16 + h) * 128 * 64; }
        const int g = h >> 3;
        scan_item<128, true, 64, false>(lds, XC + 1280 + g * 128, XC + 1024 + g * 128, 1536, XT + (size_t)(1024 + g * 128) * T, XT + (size_t)(h * 64) * T, tok0, nch, dir, s0, sfin, 64,
                             YS + (size_t)dir * T * 1024 + h * 64, 1024, DT + dir * 16 + h, p.in[18][dir * 16 + h], -__expf(p.in[17][dir * 16 + h]), nullptr);
    }
}
__device__ __forceinline__ void ret_phase(const Params& p, LAS unsigned char* lds, int rep) {
    unsigned char* ws = p.ws; unsigned* ctr = (unsigned*)(ws + O_CTL) + 1 + 2 * rep;
    const bf16_t* QR = (const bf16_t*)(ws + O_QR); const bf16_t* KR = (const bf16_t*)(ws + O_KR); const bf16_t* KRT = (const bf16_t*)(ws + O_KRT); const bf16_t* VRT = (const bf16_t*)(ws + O_VRT);
    bf16_t* YR = (bf16_t*)(ws + O_YR); const float* GP = (const float*)(ws + O_GP);
    int first_tile = 0;
    for (;;) {
        const int it = next_item(ctr, lds); if (it >= 128 + 1024) { first_tile = it; break; }
        int b, dir, h, sl, tok0, nch; const float* s0 = nullptr; float* sfin = nullptr;
        if (it < 128) { b = it >> 5; dir = (it >> 4) & 1; h = (it >> 2) & 3; sl = it & 3; tok0 = TC + b * 1024; nch = 16; s0 = p.in[5] + (size_t)((b * 2 + dir) * 4 + h) * 256 * 512 + sl * 128; }
        else { const int u = it - 128; b = u >> 5; dir = (u >> 4) & 1; h = (u >> 2) & 3; sl = u & 3; tok0 = b * 256; nch = 4; sfin = p.out + OUT_RET + (size_t)((b * 2 + dir) * 4 + h) * 256 * 512 + sl * 128; }
        const float x = p.in[30][dir * 4 + h]; const float lg = -softplusf(-x);
        scan_item<256, false, 128, true>(lds, QR + h * 256, KR + h * 256, 1024, KRT + (size_t)(h * 256) * T, VRT + (size_t)(h * 512 + sl * 128) * T, tok0, nch, dir, s0, sfin, 512,
                              YR + (size_t)dir * T * 2048 + h * 512 + sl * 128, 2048, nullptr, 0.f, lg, GP + (size_t)h * 16 * 256);
    }
    { const EpiIn1 e{(bf16_t*)(ws + O_QR), (bf16_t*)(ws + O_KR), (bf16_t*)(ws + O_KRT), (bf16_t*)(ws + O_VRT), (bf16_t*)(ws + O_GR)};
      for (int it = first_tile; it < 128 + 1024 + 384; it = next_item(ctr, lds)) { const int t = it - (128 + 1024);
          gemm_tile(lds, (const bf16_t*)(ws + O_H), (const bf16_t*)(ws + O_W1IN), 1024, (t >> 3) * 256, 4096 + (t & 7) * 256, e); } }
}

__device__ __forceinline__ void ssd_gate_phase(const Params& p) {
    unsigned char* ws = p.ws; const bf16_t* YS = (const bf16_t*)(ws + O_YS); const bf16_t* XC = (const bf16_t*)(ws + O_XC); const bf16_t* Z = (const bf16_t*)(ws + O_Z); bf16_t* MIX = (bf16_t*)(ws + O_MIX);
    const float* dsk = p.in[19]; const float* nw = p.in[20];
    const int lane = threadIdx.x & 63, gw = blockIdx.x * 8 + (threadIdx.x >> 6), nwv = gridDim.x * 8;
    for (int it = gw; it < T * 2; it += nwv) {
        const int tok = it >> 1, g = it & 1, ch = g * 512 + lane * 8;
        float a[8], b[8], x[8], z[8];
        unpack8(*(const u32x4*)(YS + (size_t)tok * 1024 + ch), a); unpack8(*(const u32x4*)(YS + (size_t)(T + tok) * 1024 + ch), b);
        unpack8(*(const u32x4*)(XC + (size_t)tok * 1536 + ch), x); unpack8(*(const u32x4*)(Z + (size_t)tok * 1024 + ch), z);
        const float d = dsk[ch >> 6]; float ss = 0.f;
#pragma unroll
        for (int e = 0; e < 8; ++e) { a[e] = (a[e] + b[e] + d * x[e]) * siluf(z[e]); ss += a[e] * a[e]; }
        ss = wave_sum(ss); const float rstd = rsqrtf(ss * (1.f / 512.f) + 1e-6f);
        const f32x4 w0 = *(const f32x4*)(nw + ch), w1 = *(const f32x4*)(nw + ch + 4);
        u32x4 o; o.x = cvt_pk_bf16(a[0] * rstd * w0[0], a[1] * rstd * w0[1]); o.y = cvt_pk_bf16(a[2] * rstd * w0[2], a[3] * rstd * w0[3]);
        o.z = cvt_pk_bf16(a[4] * rstd * w1[0], a[5] * rstd * w1[1]); o.w = cvt_pk_bf16(a[6] * rstd * w1[2], a[7] * rstd * w1[3]);
        *(u32x4*)(MIX + (size_t)tok * 1536 + 512 + ch) = o;
    }
}
__device__ __forceinline__ void ret_gate_phase(const Params& p) {
    unsigned char* ws = p.ws; const bf16_t* YR = (const bf16_t*)(ws + O_YR); const bf16_t* GR = (const bf16_t*)(ws + O_GR); bf16_t* RG = (bf16_t*)(ws + O_RG);
    const float* nw = p.in[31];
    const int lane = threadIdx.x & 63, gw = blockIdx.x * 8 + (threadIdx.x >> 6), nwv = gridDim.x * 8;
    for (int it = gw; it < T * 4; it += nwv) {
        const int tok = it >> 2, h = it & 3, ch = h * 512 + lane * 8;
        float a[8], b[8], gt[8];
        unpack8(*(const u32x4*)(YR + (size_t)tok * 2048 + ch), a); unpack8(*(const u32x4*)(YR + (size_t)(T + tok) * 2048 + ch), b); unpack8(*(const u32x4*)(GR + (size_t)tok * 2048 + ch), gt);
        float ss = 0.f;
#pragma unroll
        for (int e = 0; e < 8; ++e) { a[e] += b[e]; ss += a[e] * a[e]; }
        ss = wave_sum(ss); const float rstd = rsqrtf(ss * (1.f / 512.f) + 1e-6f);
        const f32x4 w0 = *(const f32x4*)(nw + ch), w1 = *(const f32x4*)(nw + ch + 4);
        float o[8];
#pragma unroll
        for (int e = 0; e < 8; ++e) o[e] = a[e] * rstd * (e < 4 ? w0[e] : w1[e - 4]) * siluf(gt[e]);
        u32x4 ow; ow.x = cvt_pk_bf16(o[0], o[1]); ow.y = cvt_pk_bf16(o[2], o[3]); ow.z = cvt_pk_bf16(o[4], o[5]); ow.w = cvt_pk_bf16(o[6], o[7]);
        *(u32x4*)(RG + (size_t)tok * 2048 + ch) = ow;
    }
}

#define XB_TMO      128
#define XB_XCNT(j)  (256  + 64 * (j))
#define XB_XSUB(j)  (1280 + 64 * (j))
#define XB_XGEN(j)  (2304 + 64 * (j))
#define XB_TOP      3328
#define XB_TOPGEN   3392
#define XCD_BAR_WORDS 3456
#define XB_SPIN_CAP (1u << 18)
__device__ __forceinline__ unsigned xb_ld(unsigned* p)              { return __hip_atomic_load(p, __ATOMIC_RELAXED, __HIP_MEMORY_SCOPE_AGENT); }
__device__ __forceinline__ unsigned xb_add(unsigned* p, unsigned v) { return __hip_atomic_fetch_add(p, v, __ATOMIC_RELAXED, __HIP_MEMORY_SCOPE_AGENT); }
__device__ __forceinline__ unsigned xb_xcc_id() { return (unsigned)__builtin_amdgcn_s_getreg((3 << 11) | 20) & 0xFu; }
#define XB_SPIN(cond, bar) do { unsigned _sp = 0; while (cond) { __builtin_amdgcn_s_sleep(1); \
    if ((++_sp & 255u) == 0u) { if (xb_ld(&(bar)[XB_TMO])) break; if (_sp > XB_SPIN_CAP) { atomicAdd(&(bar)[XB_TMO], 1u); break; } } } } while (0)
struct XcdBarrier { unsigned* bar; unsigned x; volatile LAS unsigned* st; };
__device__ __forceinline__ XcdBarrier xcd_barrier_post(unsigned* bar, volatile LAS unsigned* st) {
    XcdBarrier b; b.bar = bar; b.x = xb_xcc_id(); b.st = st;
    if (threadIdx.x == 0) (void)xb_add(&bar[XB_XCNT(b.x)], 1u);
    return b;
}
__device__ __forceinline__ void xcd_barrier_complete(unsigned* bar, unsigned x, unsigned& nloc, unsigned& nx) {
    const unsigned G = gridDim.x * gridDim.y * gridDim.z;
    unsigned sum, cnt, mine, sp = 0u;
    for (;;) {
        sum = 0u; cnt = 0u; mine = 0u;
#pragma unroll
        for (unsigned j = 0; j < 16; ++j) { const unsigned c = xb_ld(&bar[XB_XCNT(j)]); sum += c; cnt += (c > 0u) ? 1u : 0u; mine = (j == x) ? c : mine; }
        if (sum == G) break;
        __builtin_amdgcn_s_sleep(1);
        if ((++sp & 255u) == 0u) { if (xb_ld(&bar[XB_TMO])) break; if (sp > XB_SPIN_CAP) { atomicAdd(&bar[XB_TMO], 1u); break; } }
    }
    nloc = mine > 0u ? mine : 1u; nx = cnt > 0u ? cnt : 1u;
}
__device__ __forceinline__ void xcd_barrier(const XcdBarrier& b) {
    asm volatile("s_waitcnt vmcnt(0)" ::: "memory");
    __syncthreads();
    if (threadIdx.x == 0) {
        unsigned* bar = b.bar;
        __builtin_amdgcn_s_waitcnt(0);
        unsigned nloc = b.st[0], nx = b.st[1];
        if (nloc == 0u) { xcd_barrier_complete(bar, b.x, nloc, nx); b.st[0] = nloc; b.st[1] = nx; }
        const unsigned old = xb_add(&bar[XB_XSUB(b.x)], 1u);
        const unsigned gen = old / nloc;
        if (old + 1u == (gen + 1u) * nloc) {
            __builtin_amdgcn_fence(__ATOMIC_RELEASE, "agent");
            asm volatile("s_waitcnt vmcnt(0)" ::: "memory");
            const unsigned og = xb_add(&bar[XB_TOP], 1u);
            const unsigned tg = og / nx;
            if (og + 1u == (tg + 1u) * nx) xb_add(&bar[XB_TOPGEN], 1u);
            else XB_SPIN(xb_ld(&bar[XB_TOPGEN]) == tg, bar);
            __builtin_amdgcn_fence(__ATOMIC_ACQUIRE, "agent");
            xb_add(&bar[XB_XGEN(b.x)], 1u);
            asm volatile("s_waitcnt vmcnt(0)" ::: "memory");
        } else {
            XB_SPIN(xb_ld(&bar[XB_XGEN(b.x)]) == gen, bar);
            __builtin_amdgcn_fence(__ATOMIC_ACQUIRE, "agent");
            asm volatile("s_waitcnt vmcnt(0)" ::: "memory");
        }
    }
    __syncthreads();
}

constexpr int N_PHASES = 19;
__global__ void __launch_bounds__(NTHR) fwd_megakernel(Params p_arg) {
    const Params& p = *(const Params*)__builtin_amdgcn_kernarg_segment_ptr();
    extern __shared__ __attribute__((aligned(16))) unsigned char lds_raw[];
    LAS unsigned char* lds = (LAS unsigned char*)lds_raw;
    cg::grid_group grid = cg::this_grid();
    if (threadIdx.x < 4) ((LAS unsigned*)(lds + LDS_XB_OFF))[threadIdx.x] = 0u;
    __syncthreads();
    (void)xcd_barrier_post((unsigned*)(p.ws + O_CTL) + 256, (volatile LAS unsigned*)(lds + LDS_XB_OFF));
    unsigned char* ws = p.ws;
    float* MOD = (float*)(ws + O_MOD); bf16_t* H = (bf16_t*)(ws + O_H); float* XA = (float*)(ws + O_XA);
#ifdef ONLY_PHASE
#define PH_ON(k) ((k) == ONLY_PHASE)
#else
#define PH_ON(k) (p.ph_lo <= (k) && (k) < p.ph_hi)
#endif
#ifndef PROBE_MASK
#define PROBE_MASK 0
#endif
#define PH_BEGIN(k) if (PH_ON(k)) { for (int rep = 0; rep <= ((PROBE_MASK >> (k)) & 1); ++rep) {
#define PH_END(k) } } if (p.ph_lo <= (k) && (k) + 1 < p.ph_hi) { if ((k) == 0 && p.ph_lo < 0) grid.sync(); else { XcdBarrier xb_; xb_.bar = (unsigned*)(p.ws + O_CTL) + 256; xb_.x = xb_xcc_id(); xb_.st = (volatile LAS unsigned*)(lds + LDS_XB_OFF); xcd_barrier(xb_); } }
    PH_BEGIN(0) prep_phase(p, lds, 0, (int)blockIdx.x, (int)gridDim.x);
        if (gridDim.x <= 192) { prep_phase(p, lds, 1, (int)blockIdx.x, (int)gridDim.x); prep_phase(p, lds, 2, (int)blockIdx.x, (int)gridDim.x); } PH_END(0)
    PH_BEGIN(1) norm_phase(p.in[0], p.in[1], p.in[8], MOD, 0, 1024, H, nullptr); PH_END(1)
    PH_BEGIN(2) EpiIn0 e{(bf16_t*)(ws + O_Q0), (bf16_t*)(ws + O_K0), (bf16_t*)(ws + O_V0T), (bf16_t*)(ws + O_Z), (bf16_t*)(ws + O_XBC), (float*)(ws + O_DT), p.out + OUT_K, p.out + OUT_V};
        gemm_phase(lds, H, (const bf16_t*)(ws + O_W0IN), 4096, 1024, e); PH_END(2)
    PH_BEGIN(3) conv_phase(p, lds); na_phase(p, lds); PH_END(3)
    PH_BEGIN(4) ssd_phase(p, lds, rep); PH_END(4)
    PH_BEGIN(5) ssd_gate_phase(p); PH_END(5)
    PH_BEGIN(6) EpiRes e{p.in[0], p.in[1], XA, MOD + 2048}; gemm_phase(lds, (const bf16_t*)(ws + O_MIX), (const bf16_t*)(ws + O_W0OUT), 1024, 1536, e, &p, gridDim.x > 192 ? 1 : 0); PH_END(6)
    PH_BEGIN(7) norm_phase(XA, XA + (size_t)TC * 1024, p.in[9], MOD, 3072, 4096, H, nullptr); PH_END(7)
    PH_BEGIN(8) EpiSwiglu e{(bf16_t*)(ws + O_HID)}; gemm_phase(lds, H, (const bf16_t*)(ws + O_W0UP), 5632, 1024, e); PH_END(8)
    PH_BEGIN(9) EpiRes e{XA, XA + (size_t)TC * 1024, XA, MOD + 5120}; gemm_phase(lds, (const bf16_t*)(ws + O_HID), (const bf16_t*)(ws + O_W0DN), 1024, 2816, e, &p, gridDim.x > 192 ? 2 : 0); PH_END(9)
    PH_BEGIN(10) norm_phase(XA, XA + (size_t)TC * 1024, p.in[24], MOD + 5 * 6144, 0, 1024, H, nullptr); PH_END(10)
    PH_BEGIN(11) EpiIn1 e{(bf16_t*)(ws + O_QR), (bf16_t*)(ws + O_KR), (bf16_t*)(ws + O_KRT), (bf16_t*)(ws + O_VRT), (bf16_t*)(ws + O_GR)};
        in1_phase(p, lds, e);
        if (gridDim.x != 256) { XcdBarrier xb_; xb_.bar = (unsigned*)(p.ws + O_CTL) + 256; xb_.x = xb_xcc_id(); xb_.st = (volatile LAS unsigned*)(lds + LDS_XB_OFF); xcd_barrier(xb_); retg_phase(p); } PH_END(11)
    PH_BEGIN(12) ret_phase(p, lds, rep); PH_END(12)
    PH_BEGIN(13) ret_gate_phase(p); PH_END(13)
    PH_BEGIN(14) EpiRes e{XA, XA + (size_t)TC * 1024, XA, MOD + 5 * 6144 + 2048}; gemm_phase(lds, (const bf16_t*)(ws + O_RG), (const bf16_t*)(ws + O_W1OUT), 1024, 2048, e); PH_END(14)
    PH_BEGIN(15) norm_phase(XA, XA + (size_t)TC * 1024, p.in[25], MOD + 5 * 6144, 3072, 4096, H, nullptr); PH_END(15)
    PH_BEGIN(16) EpiSwiglu e{(bf16_t*)(ws + O_HID)}; gemm_phase(lds, H, (const bf16_t*)(ws + O_W1UP), 5632, 1024, e); PH_END(16)
    PH_BEGIN(17) EpiRes e{XA, XA + (size_t)TC * 1024, XA, MOD + 5 * 6144 + 5120}; gemm_phase(lds, (const bf16_t*)(ws + O_HID), (const bf16_t*)(ws + O_W1DN), 1024, 2816, e); PH_END(17)
    PH_BEGIN(18) norm_phase(XA, XA + (size_t)TC * 1024, p.in[35], nullptr, 0, 0, nullptr, p.out + OUT_Y); PH_END(18)
}

extern "C" void kernel_launch(void* const* d_in, const int* in_sizes, int n_in, void* d_out, int out_size, void* d_ws, size_t ws_size, hipStream_t stream) {
    static int grid_blocks = 0;
    if (grid_blocks == 0) {
        if (n_in != 36 || ws_size < WS_END) { fprintf(stderr, "kernel_launch: unexpected n_in %d / ws %zu (need %zu)\n", n_in, ws_size, (size_t)WS_END); grid_blocks = -1; return; }
        int dev = 0, cus = 0, per_cu = 0;
        hipGetDevice(&dev); hipDeviceGetAttribute(&cus, hipDeviceAttributeMultiprocessorCount, dev);
        if (hipFuncSetAttribute((const void*)fwd_megakernel, hipFuncAttributeMaxDynamicSharedMemorySize, LDS_BYTES) != hipSuccess) { fprintf(stderr, "kernel_launch: hipFuncSetAttribute failed\n"); grid_blocks = -1; return; }
        if (hipOccupancyMaxActiveBlocksPerMultiprocessor(&per_cu, (const void*)fwd_megakernel, NTHR, LDS_BYTES) != hipSuccess || per_cu < 1) { fprintf(stderr, "kernel_launch: occupancy query failed (%d)\n", per_cu); grid_blocks = -1; return; }
        grid_blocks = cus * per_cu;
    }
    if (grid_blocks < 0) return;
    hipMemsetAsync((char*)d_ws + O_CTL, 0, 16384, stream);
    Params p{};
    for (int i = 0; i < 36; ++i) p.in[i] = (const float*)d_in[i];
    p.out = (float*)d_out; p.ws = (unsigned char*)d_ws;
#if N_SPLIT
    for (int ph = 0; ph < N_PHASES; ++ph) { p.ph_lo = ph; p.ph_hi = ph + 1; void* args[] = {&p};
        hipError_t e = hipLaunchCooperativeKernel((void*)fwd_megakernel, dim3(grid_blocks), dim3(NTHR), args, LDS_BYTES, stream);
        if (e != hipSuccess) { fprintf(stderr, "launch failed: %s\n", hipGetErrorString(e)); break; } }
#else
    p.ph_lo = 0; p.ph_hi = N_PHASES; void* args[] = {&p};
    hipError_t e = hipLaunchCooperativeKernel((void*)fwd_megakernel, dim3(grid_blocks), dim3(NTHR), args, LDS_BYTES, stream);
    if (e != hipSuccess) fprintf(stderr, "cooperative launch failed: %s (grid %d)\n", hipGetErrorString(e), grid_blocks);
#endif
}
```

```cpp
#include <hip/hip_runtime.h>
#include <hip/hip_cooperative_groups.h>
#include <cstdio>
#include <cstdint>
namespace cg = cooperative_groups;

#ifndef N_SPLIT
#define N_SPLIT 0
#endif

#define LAS __attribute__((address_space(3)))
typedef unsigned short bf16_t;
typedef short bf16x8 __attribute__((ext_vector_type(8)));
typedef float f32x4 __attribute__((ext_vector_type(4)));
typedef unsigned u32x4 __attribute__((ext_vector_type(4)));
typedef unsigned u32x2 __attribute__((ext_vector_type(2)));

constexpr int T = 12288, TC = 8192, DM = 1024;
constexpr int NTHR = 512;
constexpr int LDS_BYTES = 163840;
constexpr int LDS_XB_OFF = LDS_BYTES - 16;
constexpr int FFN = 2816;

constexpr size_t al256(size_t x) { return (x + 255) & ~(size_t)255; }
constexpr size_t O_CTL   = 0;
constexpr size_t O_MOD   = 16384;
constexpr size_t O_W0IN  = al256(O_MOD + 2 * 5 * 6144 * 4);
constexpr size_t O_W0OUT = O_W0IN + (size_t)4352 * 1024 * 2;
constexpr size_t O_W0UP  = O_W0OUT + (size_t)1024 * 1536 * 2;
constexpr size_t O_W0DN  = O_W0UP + (size_t)5632 * 1024 * 2;
constexpr size_t O_W1IN  = O_W0DN + (size_t)1024 * 2816 * 2;
constexpr size_t O_W1OUT = O_W1IN + (size_t)6144 * 1024 * 2;
constexpr size_t O_W1UP  = O_W1OUT + (size_t)1024 * 2048 * 2;
constexpr size_t O_W1DN  = O_W1UP + (size_t)5632 * 1024 * 2;
constexpr size_t O_CK    = O_W1DN + (size_t)1024 * 2816 * 2;
constexpr size_t O_CVT   = O_CK + (size_t)4 * 256 * 512 * 2;
constexpr size_t O_H     = O_CVT + (size_t)4 * 512 * 256 * 2;
constexpr size_t O_XA    = O_H + (size_t)T * 1024 * 2;
constexpr size_t O_Q0    = O_XA + (size_t)T * 1024 * 4;
constexpr size_t O_K0    = O_Q0 + (size_t)T * 512 * 2;
constexpr size_t O_V0T   = O_K0 + (size_t)T * 512 * 2;
constexpr size_t O_Z     = O_V0T + (size_t)T * 512 * 2;
constexpr size_t O_XBC   = O_Z + (size_t)T * 1024 * 2;
constexpr size_t O_DT    = O_XBC + (size_t)T * 1536 * 2;
constexpr size_t O_XC    = O_DT + (size_t)T * 32 * 4;
constexpr size_t O_XT    = O_XC + (size_t)T * 1536 * 2;
constexpr size_t O_YS    = O_XT + (size_t)1280 * T * 2;
constexpr size_t O_MIX   = O_YS + (size_t)2 * T * 1024 * 2;
constexpr size_t O_HID   = O_MIX + (size_t)T * 1536 * 2;
constexpr size_t O_QR    = O_HID + (size_t)T * 2816 * 2;
constexpr size_t O_KR    = O_QR + (size_t)T * 1024 * 2;
constexpr size_t O_KRT   = O_KR + (size_t)T * 1024 * 2;
constexpr size_t O_VRT   = O_KRT + (size_t)T * 1024 * 2;
constexpr size_t O_GR    = O_VRT + (size_t)T * 2048 * 2;
constexpr size_t O_YR    = O_GR + (size_t)T * 2048 * 2;
constexpr size_t O_RG    = O_YR + (size_t)2 * T * 2048 * 2;
constexpr size_t O_GP    = O_RG + (size_t)T * 2048 * 2;
constexpr size_t WS_END  = O_GP + (size_t)192 * 4 * 16 * 256 * 4;

constexpr size_t OUT_Y = 0, OUT_K = (size_t)T * 1024, OUT_V = OUT_K + (size_t)TC * 512, OUT_SSD = OUT_V + (size_t)TC * 512,
                 OUT_RET = OUT_SSD + (size_t)32 * 2 * 16 * 128 * 64;

struct Params { const float* in[36]; float* out; unsigned char* ws; int ph_lo, ph_hi; };

typedef float f32x2 __attribute__((ext_vector_type(2)));
typedef __bf16 nbf16x2 __attribute__((ext_vector_type(2)));
__device__ __forceinline__ unsigned cvt_pk_bf16(float lo, float hi) { const f32x2 v = {lo, hi}; const nbf16x2 b = __builtin_convertvector(v, nbf16x2); return __builtin_bit_cast(unsigned, b); }
__device__ __forceinline__ bf16_t f2bf(float x) { return (bf16_t)(cvt_pk_bf16(x, 0.f) & 0xffffu); }
__device__ __forceinline__ float bf_lo(unsigned w) { return __uint_as_float(w << 16); }
__device__ __forceinline__ float bf_hi(unsigned w) { return __uint_as_float(w & 0xffff0000u); }
__device__ __forceinline__ float bf2f(bf16_t b) { return __uint_as_float((unsigned)b << 16); }
__device__ __forceinline__ void unpack8(u32x4 w, float (&x)[8]) { x[0] = bf_lo(w.x); x[1] = bf_hi(w.x); x[2] = bf_lo(w.y); x[3] = bf_hi(w.y); x[4] = bf_lo(w.z); x[5] = bf_hi(w.z); x[6] = bf_lo(w.w); x[7] = bf_hi(w.w); }
__device__ __forceinline__ float siluf(float x) { return x * __builtin_amdgcn_rcpf(1.f + __expf(-x)); }
__device__ __forceinline__ float softplusf(float x) { return x > 20.f ? x : log1pf(__expf(x)); }
__device__ __forceinline__ bf16x8 as_bf16x8(u32x4 v) { return __builtin_bit_cast(bf16x8, v); }
__device__ __forceinline__ f32x4 mfma16(bf16x8 a, bf16x8 b, f32x4 c) { return __builtin_amdgcn_mfma_f32_16x16x32_bf16(a, b, c, 0, 0, 0); }
__device__ __forceinline__ float wave_sum(float v) {
#pragma unroll
    for (int o = 32; o >= 1; o >>= 1) v += __shfl_xor(v, o);
    return v;
}

constexpr int BM = 256, BK = 64, HALF = 128, HTB = HALF * BK * 2;
__device__ __forceinline__ int lds_byte(int r, int c) { const int st = (r >> 4) * 2 + (c >> 5), rr = r & 15, cc = c & 31, ob = rr * 64 + cc * 2; return st * 1024 + (ob ^ (((ob >> 9) & 1) << 5)); }
__device__ __forceinline__ void stage_rc(int b, int& R, int& C) { const int st = b / 1024, sb = b % 1024, swz = sb ^ (((sb >> 9) & 1) << 5); R = (st >> 1) * 16 + swz / 64; C = (st & 1) * 32 + (swz % 64) / 2; }

__device__ __forceinline__ bool tile_of(int L, int nM, int nN, int& pm, int& pn) {
    const int nwg = nM * nN; if (L >= nwg) return false;
    int wgid = L; { const int q = nwg / 8, r = nwg % 8, xcd = wgid % 8, off = wgid / 8; wgid = (xcd < r ? xcd * (q + 1) : r * (q + 1) + (xcd - r) * q) + off; }
    const int nig = 8 * nN, gid = wgid / nig, fm = gid * 8, gsz = (nM - fm) < 8 ? (nM - fm) : 8;
    pm = fm + ((wgid % nig) % gsz); pn = (wgid % nig) / gsz; return true;
}

__device__ __forceinline__ void gemm_core(LAS unsigned char* lds, const bf16_t* __restrict__ A, const bf16_t* __restrict__ Bt, const int K, const int brow, const int bcol, const int k0, const int klen, f32x4 (&acc)[2][2][4][2]) {
    const int tid = threadIdx.x, wid = __builtin_amdgcn_readfirstlane(tid >> 6), lane = tid & 63, wr = wid >> 2, wc = wid & 3, fr = lane & 15, fq = lane >> 4;
    unsigned voff[2], voffB[2];
#pragma unroll
    for (int i = 0; i < 2; ++i) { int R, C; stage_rc(tid * 16 + i * 8192, R, C); voff[i] = (unsigned)(R * K + C) * 2u;
        const int rho = R & 31, Rb = (R & ~31) + 8 * ((rho & 15) >> 2) + 4 * (rho >> 4) + (rho & 3); voffB[i] = (unsigned)(Rb * K + C) * 2u; }
    const unsigned ldsw = (unsigned)wid * 1024u;
    const int aoff = lds_byte(wr * 64 + fr, fq * 8), boff = lds_byte(wc * 32 + fr, fq * 8);
    const char* cA = (const char*)(A + (size_t)brow * K + k0); const char* cB = (const char*)(Bt + (size_t)bcol * K + k0);
    const size_t kstep = (size_t)BK * 2, hstep = (size_t)HALF * K * 2;
#define SA(b, h) (((b) * 2 + (h)) * HTB)
#define SB(b, h) ((4 + (b) * 2 + (h)) * HTB)
#define STAGE(bufoff, gbase) do { _Pragma("unroll") for (int _i = 0; _i < 2; ++_i) \
        __builtin_amdgcn_global_load_lds((const unsigned*)((gbase) + ((bufoff) >= 4 * HTB ? voffB[_i] : voff[_i])), (LAS unsigned*)(lds + (bufoff) + ldsw + _i * 8192), 16, 0, 0); } while (0)
#define LDA(dst, b, h) do { _Pragma("unroll") for (int m = 0; m < 4; ++m) _Pragma("unroll") for (int k = 0; k < 2; ++k) dst[m][k] = *(const LAS bf16x8*)(lds + SA(b, h) + aoff + m * 2048 + k * 1024); } while (0)
#define LDB(dst, b, h) do { _Pragma("unroll") for (int n = 0; n < 2; ++n) _Pragma("unroll") for (int k = 0; k < 2; ++k) dst[n][k] = *(const LAS bf16x8*)(lds + SB(b, h) + boff + n * 2048 + k * 1024); } while (0)
#define MMA(ai, bj, At, Bt_) do { __builtin_amdgcn_s_setprio(1); _Pragma("unroll") for (int m = 0; m < 4; ++m) _Pragma("unroll") for (int n = 0; n < 2; ++n) _Pragma("unroll") for (int k = 0; k < 2; ++k) \
        acc[ai][bj][m][n] = __builtin_amdgcn_mfma_f32_16x16x32_bf16(Bt_[n][k], At[m][k], acc[ai][bj][m][n], 0, 0, 0); __builtin_amdgcn_s_setprio(0); } while (0)
#define WAIT_V(n) asm volatile("s_waitcnt vmcnt(" #n ")" ::: "memory")
#define WAIT_L(n) asm volatile("s_waitcnt lgkmcnt(" #n ")" ::: "memory")
#define BAR __builtin_amdgcn_s_barrier()
#define SCHED __builtin_amdgcn_sched_barrier(0)
    bf16x8 At[4][2], B0[2][2], B1[2][2];
    const int nt = klen / BK;
    STAGE(SB(0, 0), cB); STAGE(SA(0, 0), cA); STAGE(SB(0, 1), cB + hstep); STAGE(SA(0, 1), cA + hstep);
    if (wr == 1) BAR;
    WAIT_V(4); BAR;
    STAGE(SB(1, 0), cB + kstep); STAGE(SA(1, 0), cA + kstep); STAGE(SB(1, 1), cB + hstep + kstep);
    WAIT_V(6); BAR;
    for (int t = 0; t < nt - 2; t += 2) {
        const char* a1 = cA + (size_t)(t + 1) * kstep; const char* a2 = cA + (size_t)(t + 2) * kstep; const char* b2 = cB + (size_t)(t + 2) * kstep;
        const char* a3 = a2 + kstep; const char* b3 = b2 + kstep;
        LDB(B0, 0, 0); SCHED; LDA(At, 0, 0); STAGE(SA(1, 1), a1 + hstep);
        WAIT_L(8); BAR; WAIT_L(0); MMA(0, 0, At, B0); BAR; SCHED;
        LDB(B1, 0, 1); STAGE(SB(0, 0), b2);
        BAR; WAIT_L(0); MMA(0, 1, At, B1); BAR;
        LDA(At, 0, 1); STAGE(SA(0, 0), a2);
        BAR; WAIT_L(0); MMA(1, 0, At, B0); BAR; SCHED;
        STAGE(SB(0, 1), b2 + hstep);
        WAIT_V(6); BAR; MMA(1, 1, At, B1); BAR;
        LDB(B0, 1, 0); SCHED; LDA(At, 1, 0); STAGE(SA(0, 1), a2 + hstep);
        WAIT_L(8); BAR; WAIT_L(0); MMA(0, 0, At, B0); BAR; SCHED;
        LDB(B1, 1, 1); STAGE(SB(1, 0), b3);
        BAR; WAIT_L(0); MMA(0, 1, At, B1); BAR;
        LDA(At, 1, 1); STAGE(SA(1, 0), a3);
        BAR; WAIT_L(0); MMA(1, 0, At, B0); BAR; SCHED;
        STAGE(SB(1, 1), b3 + hstep);
        WAIT_V(6); BAR; MMA(1, 1, At, B1); BAR;
    }
    { const char* a1 = cA + (size_t)(nt - 1) * kstep;
      LDB(B0, 0, 0); LDA(At, 0, 0); STAGE(SA(1, 1), a1 + hstep);
      BAR; WAIT_L(0); MMA(0, 0, At, B0); BAR;
      LDB(B1, 0, 1); BAR; WAIT_L(0); MMA(0, 1, At, B1); BAR;
      LDA(At, 0, 1); WAIT_V(4); BAR; WAIT_L(0); MMA(1, 0, At, B0); MMA(1, 1, At, B1); BAR; }
    { LDB(B0, 1, 0); LDA(At, 1, 0); WAIT_V(2); BAR; WAIT_L(0); MMA(0, 0, At, B0); BAR;
      LDB(B1, 1, 1); WAIT_V(0); BAR; WAIT_L(0); MMA(0, 1, At, B1); BAR;
      LDA(At, 1, 1); BAR; WAIT_L(0); MMA(1, 0, At, B0); MMA(1, 1, At, B1); BAR; }
    if (wr == 0) BAR;
#undef SA
#undef SB
#undef STAGE
#undef LDA
#undef LDB
#undef MMA
#undef WAIT_V
#undef WAIT_L
#undef BAR
#undef SCHED
}
__device__ __forceinline__ void acc_zero(f32x4 (&acc)[2][2][4][2]) {
#pragma unroll
    for (int a = 0; a < 2; ++a)
#pragma unroll
        for (int b = 0; b < 2; ++b)
#pragma unroll
            for (int m = 0; m < 4; ++m)
#pragma unroll
                for (int n = 0; n < 2; ++n) acc[a][b][m][n] = (f32x4){0.f, 0.f, 0.f, 0.f};
}
template <class Epi>
__device__ __forceinline__ void gemm_tile(LAS unsigned char* lds, const bf16_t* __restrict__ A, const bf16_t* __restrict__ Bt, const int K, const int brow, const int bcol, const Epi& epi) {
    const int tid = threadIdx.x, wid = __builtin_amdgcn_readfirstlane(tid >> 6), lane = tid & 63, wr = wid >> 2, wc = wid & 3, fr = lane & 15, fq = lane >> 4;
    f32x4 acc[2][2][4][2]; acc_zero(acc);
    gemm_core(lds, A, Bt, K, brow, bcol, 0, K, acc);
    epi(acc, brow, bcol, wr, wc, fr, fq);
    asm volatile("s_waitcnt vmcnt(0)" ::: "memory");
    __syncthreads();
}

template <class F>
__device__ __forceinline__ void epi_each(const f32x4 (&acc)[2][2][4][2], int brow, int bcol, int wr, int wc, int fr, int fq, F f) {
#pragma unroll
    for (int ai = 0; ai < 2; ++ai)
#pragma unroll
        for (int m = 0; m < 4; ++m)
#pragma unroll
            for (int bj = 0; bj < 2; ++bj) f(brow + ai * 128 + wr * 64 + m * 16 + fr, bcol + bj * 128 + wc * 32 + fq * 8, acc[ai][bj][m][0], acc[ai][bj][m][1]);
}
__device__ __forceinline__ void st_bf16x4(bf16_t* p, f32x4 v) { u32x2 w; w.x = cvt_pk_bf16(v[0], v[1]); w.y = cvt_pk_bf16(v[2], v[3]); *(u32x2*)p = w; }
__device__ __forceinline__ void st_bf16x8(bf16_t* p, f32x4 a, f32x4 b) { u32x4 w; w.x = cvt_pk_bf16(a[0], a[1]); w.y = cvt_pk_bf16(a[2], a[3]); w.z = cvt_pk_bf16(b[0], b[1]); w.w = cvt_pk_bf16(b[2], b[3]); *(u32x4*)p = w; }
__device__ __forceinline__ void st_bf16_T(bf16_t* base, size_t col, int row, f32x4 v) {
#pragma unroll
    for (int j = 0; j < 4; ++j) base[(col + j) * (size_t)T + row] = f2bf(v[j]);
}

struct EpiIn0 {
    bf16_t *Q0, *K0, *V0T, *Z, *XBC; float *DT, *outK, *outV;
    __device__ __forceinline__ void operator()(const f32x4 (&acc)[2][2][4][2], int brow, int bcol, int wr, int wc, int fr, int fq) const {
        if (bcol < 512) epi_each(acc, brow, bcol, wr, wc, fr, fq, [&](int r, int c, f32x4 v, f32x4 w) { st_bf16x8(Q0 + (size_t)r * 512 + c, v * 0.125f, w * 0.125f); });
        else if (bcol < 1024) epi_each(acc, brow, bcol, wr, wc, fr, fq, [&](int r, int c, f32x4 v, f32x4 w) { c -= 512; st_bf16x8(K0 + (size_t)r * 512 + c, v, w);
            if (r < TC) { *(f32x4*)(outK + (size_t)r * 512 + c) = v; *(f32x4*)(outK + (size_t)r * 512 + c + 4) = w; } });
        else if (bcol < 1536) epi_each(acc, brow, bcol, wr, wc, fr, fq, [&](int r, int c, f32x4 v, f32x4 w) { c -= 1024; st_bf16_T(V0T, c, r, v); st_bf16_T(V0T, c + 4, r, w);
            if (r < TC) { *(f32x4*)(outV + (size_t)r * 512 + c) = v; *(f32x4*)(outV + (size_t)r * 512 + c + 4) = w; } });
        else if (bcol < 2560) epi_each(acc, brow, bcol, wr, wc, fr, fq, [&](int r, int c, f32x4 v, f32x4 w) { st_bf16x8(Z + (size_t)r * 1024 + (c - 1536), v, w); });
        else epi_each(acc, brow, bcol, wr, wc, fr, fq, [&](int r, int c, f32x4 v, f32x4 w) { st_bf16x8(XBC + (size_t)r * 1536 + (c - 2560), v, w); });
    }
};
struct EpiRes {
    const float *baseA, *baseB;
    float* XA; const float* gate;
    __device__ __forceinline__ void operator()(const f32x4 (&acc)[2][2][4][2], int brow, int bcol, int wr, int wc, int fr, int fq) const {
        const float* base = brow < TC ? baseA : baseB - (size_t)TC * 1024;
        const float* g = gate + (brow < TC ? 0 : (1 + (brow - TC) / 1024) * 6144);
        const int cb = bcol + wc * 32 + fq * 8;
        const f32x4 g00 = *(const f32x4*)(g + cb), g01 = *(const f32x4*)(g + cb + 4), g10 = *(const f32x4*)(g + cb + 128), g11 = *(const f32x4*)(g + cb + 132);
        epi_each(acc, brow, bcol, wr, wc, fr, fq, [&](int r, int c, f32x4 v, f32x4 w) {
            const f32x4 b0 = *(const f32x4*)(base + (size_t)r * 1024 + c), b1 = *(const f32x4*)(base + (size_t)r * 1024 + c + 4); const bool hi = (c - cb) != 0;
            *(f32x4*)(XA + (size_t)r * 1024 + c) = b0 + (hi ? g10 : g00) * v; *(f32x4*)(XA + (size_t)r * 1024 + c + 4) = b1 + (hi ? g11 : g01) * w; });
    }
};
struct EpiSwiglu {
    bf16_t* HID;
    __device__ __forceinline__ void operator()(const f32x4 (&acc)[2][2][4][2], int brow, int bcol, int wr, int wc, int fr, int fq) const {
        const int hc0 = (bcol >> 1) + wc * 32 + fq * 8;
#pragma unroll
        for (int ai = 0; ai < 2; ++ai)
#pragma unroll
            for (int m = 0; m < 4; ++m) {
                f32x4 o[2];
#pragma unroll
                for (int n = 0; n < 2; ++n) { const f32x4 a = acc[ai][0][m][n], b = acc[ai][1][m][n];
#pragma unroll
                    for (int j = 0; j < 4; ++j) o[n][j] = siluf(a[j]) * b[j]; }
                st_bf16x8(HID + (size_t)(brow + ai * 128 + wr * 64 + m * 16 + fr) * FFN + hc0, o[0], o[1]);
            }
    }
};
__device__ __forceinline__ f32x4 rope4(f32x4 v, int r, int c) {
    const int t = (r - TC) & 1023, grow = t >> 6, gcol = t & 63, d = c & 255, p0 = d >> 1;
    f32x4 o;
#pragma unroll
    for (int q = 0; q < 2; ++q) {
        const int p = p0 + q; const float pos = (float)(p < 64 ? grow : gcol);
        const float fr_ = exp2f(-(float)(p & 63) * (13.287712379549449f / 64.f));
        const float ang = pos * fr_; const float cs = __cosf(ang), sn = __sinf(ang);
        const float x1 = v[2 * q], x2 = v[2 * q + 1];
        o[2 * q] = x1 * cs - x2 * sn; o[2 * q + 1] = x1 * sn + x2 * cs;
    }
    return o;
}
struct EpiIn1 {
    bf16_t *QR, *KR, *KRT, *VRT, *GR;
    __device__ __forceinline__ void operator()(const f32x4 (&acc)[2][2][4][2], int brow, int bcol, int wr, int wc, int fr, int fq) const {
        const bool lat = brow >= TC;
        if (bcol < 1024) epi_each(acc, brow, bcol, wr, wc, fr, fq, [&](int r, int c, f32x4 v, f32x4 w) { if (lat) { v = rope4(v, r, c); w = rope4(w, r, c + 4); } st_bf16x8(QR + (size_t)r * 1024 + c, v, w); });
        else if (bcol < 2048) epi_each(acc, brow, bcol, wr, wc, fr, fq, [&](int r, int c, f32x4 v, f32x4 w) { c -= 1024; v = v * 0.0625f; w = w * 0.0625f; if (lat) { v = rope4(v, r, c); w = rope4(w, r, c + 4); }
            st_bf16x8(KR + (size_t)r * 1024 + c, v, w); st_bf16_T(KRT, c, r, v); st_bf16_T(KRT, c + 4, r, w); });
        else if (bcol < 4096) epi_each(acc, brow, bcol, wr, wc, fr, fq, [&](int r, int c, f32x4 v, f32x4 w) { st_bf16_T(VRT, c - 2048, r, v); st_bf16_T(VRT, c - 2048 + 4, r, w); });
        else epi_each(acc, brow, bcol, wr, wc, fr, fq, [&](int r, int c, f32x4 v, f32x4 w) { st_bf16x8(GR + (size_t)r * 2048 + (c - 4096), v, w); });
    }
};

__device__ __forceinline__ void prep_phase(const Params& p, LAS unsigned char* lds, const int part, const int bx, const int G);
template <class Epi>
__device__ __forceinline__ void gemm_phase(LAS unsigned char* lds, const bf16_t* A, const bf16_t* Bt, int N, int K, const Epi& epi, const Params* pp = nullptr, int idle_part = 0) {
    const int nM = T / BM, nN = N / BM;
    if (idle_part && (int)blockIdx.x >= nM * nN) { prep_phase(*pp, lds, idle_part, (int)blockIdx.x - nM * nN, (int)gridDim.x - nM * nN); return; }
    for (int i = 0;; ++i) { int pm, pn; if (!tile_of(i * (int)gridDim.x + (int)blockIdx.x, nM, nN, pm, pn)) break; gemm_tile(lds, A, Bt, K, pm * BM, pn * BM, epi); }
}

__device__ __forceinline__ void down_phase(const Params& p, LAS unsigned char* lds, const bf16_t* Hn, const bf16_t* Wup, const bf16_t* Wdn, const EpiRes& er, unsigned* flags, int idle_part) {
    unsigned char* ws = p.ws; bf16_t* HID = (bf16_t*)(ws + O_HID);
    const int bx = (int)blockIdx.x, tid = threadIdx.x;
    if (bx < 192) {
        int pm, pn; tile_of(bx, T / BM, 4, pm, pn);
        const int wid = __builtin_amdgcn_readfirstlane(tid >> 6), lane = tid & 63, wr = wid >> 2, wc = wid & 3, fr = lane & 15, fq = lane >> 4;
        f32x4 acc[2][2][4][2]; acc_zero(acc);
        gemm_core(lds, HID, Wdn, FFN, pm * BM, pn * BM, 0, 2560, acc);
        if (tid == 0) { unsigned sp = 0; while (__hip_atomic_load(flags + pm, __ATOMIC_RELAXED, __HIP_MEMORY_SCOPE_AGENT) == 0u && ++sp < (1u << 22)) __builtin_amdgcn_s_sleep(2);
            __builtin_amdgcn_fence(__ATOMIC_ACQUIRE, "agent"); asm volatile("s_waitcnt vmcnt(0)" ::: "memory"); }
        __syncthreads();
        gemm_core(lds, HID, Wdn, FFN, pm * BM, pn * BM, 2560, 256, acc);
        er(acc, pm * BM, pn * BM, wr, wc, fr, fq);
        asm volatile("s_waitcnt vmcnt(0)" ::: "memory");
        __syncthreads();
    } else {
        const int i = bx - 192;
        if (i < 48) { const EpiSwiglu es{HID}; gemm_tile(lds, Hn, Wup, 1024, i * BM, 21 * BM, es);
            if (tid == 0) { __builtin_amdgcn_fence(__ATOMIC_RELEASE, "agent"); asm volatile("s_waitcnt vmcnt(0)" ::: "memory");
                __hip_atomic_store(flags + i, 1u, __ATOMIC_RELAXED, __HIP_MEMORY_SCOPE_AGENT); } }
        if (idle_part) prep_phase(p, lds, idle_part, i, (int)gridDim.x - 192);
    }
}

__device__ __forceinline__ void transpose_tile(LAS unsigned char* lds, const float* __restrict__ src, int N, int k0, int n0, bf16_t* __restrict__ dst, int drow0, int ldd) {
    LAS float* tl = (LAS float*)lds; const int tid = threadIdx.x;
#pragma unroll
    for (int i = 0; i < 2; ++i) { const int r = (tid >> 4) + 32 * i, c = (tid & 15) * 4;
        f32x4 v = (f32x4){0.f, 0.f, 0.f, 0.f}; if (n0 + c < N) v = *(const f32x4*)(src + (size_t)(k0 + r) * N + n0 + c);
        tl[r * 65 + c] = v[0]; tl[r * 65 + c + 1] = v[1]; tl[r * 65 + c + 2] = v[2]; tl[r * 65 + c + 3] = v[3]; }
    __syncthreads();
    { const int n = tid >> 3, kg = (tid & 7) * 8; float x[8];
#pragma unroll
      for (int e = 0; e < 8; ++e) x[e] = tl[(kg + e) * 65 + n];
      u32x4 w; w.x = cvt_pk_bf16(x[0], x[1]); w.y = cvt_pk_bf16(x[2], x[3]); w.z = cvt_pk_bf16(x[4], x[5]); w.w = cvt_pk_bf16(x[6], x[7]);
      *(u32x4*)(dst + (size_t)(drow0 + n) * ldd + k0 + kg) = w; }
    __syncthreads();
}
struct TJob { const float* src; bf16_t* dst; int K, N, Npad, mode; };
__device__ __forceinline__ void prep_phase(const Params& p, LAS unsigned char* lds, const int part, const int bx, const int G) {
    unsigned char* ws = p.ws; const int tid = threadIdx.x;
    const int mod_lo = part == 0 ? 0 : 96, mod_hi = part == 0 ? 96 : (part == 1 ? 192 : 96), job_lo = part == 0 ? 0 : 5, job_hi = part == 0 ? 5 : (part == 2 ? 10 : 5);
    float* MOD = (float*)(ws + O_MOD);
    if (mod_lo + bx < mod_hi) {
        LAS float* sc = (LAS float*)lds;
        LAS float* part = sc + 5 * 1024;
        for (int u = tid; u < 5 * 1024; u += NTHR) { const int ci = u >> 10, k = u & 1023; const float c = ci == 0 ? p.in[7][k] : p.in[6][(ci - 1) * 1024 + k]; sc[u] = siluf(c); }
        __syncthreads();
        for (int it = mod_lo + bx; it < mod_hi; it += G) {
            const int l = it / 96, n0 = (it % 96) * 64; const float* W = p.in[l == 0 ? 10 : 26]; const float* Bv = p.in[l == 0 ? 11 : 27];
            const int w = tid >> 6, lane = tid & 63; float a[5] = {0.f, 0.f, 0.f, 0.f, 0.f};
            for (int k = w * 128; k < w * 128 + 128; ++k) { const float wv = W[(size_t)k * 6144 + n0 + lane];
#pragma unroll
                for (int ci = 0; ci < 5; ++ci) a[ci] += sc[ci * 1024 + k] * wv; }
#pragma unroll
            for (int ci = 0; ci < 5; ++ci) part[(w * 5 + ci) * 64 + lane] = a[ci];
            __syncthreads();
            if (tid < 320) { const int ci = tid >> 6, ln = tid & 63; float s = 0.f;
#pragma unroll
                for (int w2 = 0; w2 < 8; ++w2) s += part[(w2 * 5 + ci) * 64 + ln];
                MOD[(size_t)(l * 5 + ci) * 6144 + n0 + ln] = s + Bv[n0 + ln]; }
            __syncthreads();
        }
    }
    if (part == 0) { bf16_t* CK = (bf16_t*)(ws + O_CK); const float* src = p.in[2];
      for (int u = bx * NTHR + tid; u < 4 * 256 * 512 / 4; u += G * NTHR) { const f32x4 v = *(const f32x4*)(src + (size_t)u * 4); st_bf16x4(CK + (size_t)u * 4, v); } }
    for (int j = job_lo; j < (part == 0 ? 14 : job_hi); ++j) {
        if (part == 0 && j >= 5 && j < 10) continue;
        TJob jb;
        switch (j) {
            case 0: jb = {p.in[12], (bf16_t*)(ws + O_W0IN), 1024, 4128, 4352, 0}; break;
            case 1: jb = {p.in[13], (bf16_t*)(ws + O_W0OUT), 1536, 1024, 1024, 0}; break;
            case 2: jb = {p.in[21], (bf16_t*)(ws + O_W0UP), 1024, 2816, 2816, 1}; break;
            case 3: jb = {p.in[22], (bf16_t*)(ws + O_W0UP), 1024, 2816, 2816, 2}; break;
            case 4: jb = {p.in[23], (bf16_t*)(ws + O_W0DN), 2816, 1024, 1024, 0}; break;
            case 5: jb = {p.in[28], (bf16_t*)(ws + O_W1IN), 1024, 6144, 6144, 0}; break;
            case 6: jb = {p.in[29], (bf16_t*)(ws + O_W1OUT), 2048, 1024, 1024, 0}; break;
            case 7: jb = {p.in[32], (bf16_t*)(ws + O_W1UP), 1024, 2816, 2816, 1}; break;
            case 8: jb = {p.in[33], (bf16_t*)(ws + O_W1UP), 1024, 2816, 2816, 2}; break;
            case 9: jb = {p.in[34], (bf16_t*)(ws + O_W1DN), 2816, 1024, 1024, 0}; break;
            default: jb = {p.in[3] + (size_t)(j - 10) * 256 * 512, (bf16_t*)(ws + O_CVT) + (size_t)(j - 10) * 512 * 256, 256, 512, 512, 0}; break;
        }
        const int nkt = jb.K / 64, nnt = jb.Npad / 64, ntile = nkt * nnt;
        for (int tix = (bx + 64 * j) % G; tix < ntile; tix += G) {
            const int kt = tix % nkt, ntl = tix / nkt, n0 = ntl * 64;
            int drow0 = n0; if (jb.mode) drow0 = (n0 / 128) * 256 + (n0 % 128) + (jb.mode == 2 ? 128 : 0);
            transpose_tile(lds, jb.src, jb.N, kt * 64, n0, jb.dst, drow0, jb.K);
        }
    }
}

__device__ __forceinline__ void norm_phase(const float* xa, const float* xb, const float* nw, const float* mod  , int sh_off, int sc_off, bf16_t* H, float* outf) {
    const int lane = threadIdx.x & 63, gw = blockIdx.x * 8 + (threadIdx.x >> 6), nw_tot = gridDim.x * 8;
    for (int r0 = gw; r0 < T; r0 += 2 * nw_tot) {
        const int r1 = r0 + nw_tot < T ? r0 + nw_tot : r0;
        f32x4 v[2][4]; float ss[2];
#pragma unroll
        for (int u = 0; u < 2; ++u) { const int r = u ? r1 : r0; const float* x = r < TC ? xa + (size_t)r * 1024 : xb + (size_t)(r - TC) * 1024; ss[u] = 0.f;
#pragma unroll
            for (int q = 0; q < 4; ++q) { v[u][q] = *(const f32x4*)(x + (q >> 1) * 512 + lane * 8 + (q & 1) * 4); ss[u] += v[u][q][0] * v[u][q][0] + v[u][q][1] * v[u][q][1] + v[u][q][2] * v[u][q][2] + v[u][q][3] * v[u][q][3]; } }
#pragma unroll
        for (int u = 0; u < 2; ++u) {
            const int r = u ? r1 : r0; if (u && r1 == r0) break;
            const float rstd = rsqrtf(wave_sum(ss[u]) * (1.f / 1024.f) + 1e-6f);
            if (outf) {
#pragma unroll
                for (int q = 0; q < 4; ++q) { const int c = (q >> 1) * 512 + lane * 8 + (q & 1) * 4; const f32x4 w = *(const f32x4*)(nw + c); *(f32x4*)(outf + (size_t)r * 1024 + c) = v[u][q] * rstd * w; }
            } else {
                const float* md = mod + (r < TC ? 0 : (1 + (r - TC) / 1024) * 6144);
#pragma unroll
                for (int h2 = 0; h2 < 2; ++h2) { const int c = h2 * 512 + lane * 8; f32x4 o[2];
#pragma unroll
                    for (int e = 0; e < 2; ++e) { const f32x4 w = *(const f32x4*)(nw + c + 4 * e), sc = *(const f32x4*)(md + sc_off + c + 4 * e), sh = *(const f32x4*)(md + sh_off + c + 4 * e);
                        o[e] = v[u][h2 * 2 + e] * rstd * w * (sc + 1.f) + sh; }
                    st_bf16x8(H + (size_t)r * 1024 + c, o[0], o[1]); }
            }
        }
    }
}

__device__ __forceinline__ void conv_phase(const Params& p, LAS unsigned char* lds) {
    unsigned char* ws = p.ws; const bf16_t* XBC = (const bf16_t*)(ws + O_XBC); bf16_t* XC = (bf16_t*)(ws + O_XC); bf16_t* XT = (bf16_t*)(ws + O_XT);
    const float* cw = p.in[15]; const float* cb = p.in[16];
    const int tid = threadIdx.x; LAS bf16_t* tl = (LAS bf16_t*)lds;
    for (int it = blockIdx.x; it < 96 * 24; it += gridDim.x) {
        const int tt = it / 24, ct = it % 24, tok0 = tt * 128, c0 = ct * 64;
        const int L = tok0 < TC ? 256 : 1024, ts0 = tok0 < TC ? (tok0 & 255) : ((tok0 - TC) & 1023);
        const int tp = (tid >> 3) * 2, cg_ = (tid & 7) * 8, tok = tok0 + tp, ts = ts0 + tp, ch = c0 + cg_;
        u32x4 rw[6];
#pragma unroll
        for (int k = 0; k < 6; ++k) { const int tsk = ts + k - 2; rw[k] = (u32x4){0u, 0u, 0u, 0u}; if (tsk >= 0 && tsk < L) rw[k] = *(const u32x4*)(XBC + (size_t)(tok + k - 2) * 1536 + ch); }
        float a0[8], a1[8];
        { const f32x4 b0 = *(const f32x4*)(cb + ch), b1 = *(const f32x4*)(cb + ch + 4);
#pragma unroll
          for (int e = 0; e < 4; ++e) { a0[e] = b0[e]; a0[e + 4] = b1[e]; a1[e] = b0[e]; a1[e + 4] = b1[e]; } }
#pragma unroll
        for (int k = 0; k < 5; ++k) { const f32x4 w0 = *(const f32x4*)(cw + k * 1536 + ch), w1 = *(const f32x4*)(cw + k * 1536 + ch + 4);
            float x0[8], x1[8]; unpack8(rw[k], x0); unpack8(rw[k + 1], x1);
#pragma unroll
            for (int e = 0; e < 8; ++e) { const float wv = e < 4 ? w0[e] : w1[e - 4]; a0[e] += wv * x0[e]; a1[e] += wv * x1[e]; } }
#pragma unroll
        for (int e = 0; e < 8; ++e) { a0[e] = siluf(a0[e]); a1[e] = siluf(a1[e]); }
        u32x4 o0, o1; o0.x = cvt_pk_bf16(a0[0], a0[1]); o0.y = cvt_pk_bf16(a0[2], a0[3]); o0.z = cvt_pk_bf16(a0[4], a0[5]); o0.w = cvt_pk_bf16(a0[6], a0[7]);
        o1.x = cvt_pk_bf16(a1[0], a1[1]); o1.y = cvt_pk_bf16(a1[2], a1[3]); o1.z = cvt_pk_bf16(a1[4], a1[5]); o1.w = cvt_pk_bf16(a1[6], a1[7]);
        *(u32x4*)(XC + (size_t)tok * 1536 + ch) = o0; *(u32x4*)(XC + (size_t)(tok + 1) * 1536 + ch) = o1;
        if (ct < 20) {
#pragma unroll
            for (int e = 0; e < 8; ++e) *(LAS unsigned*)(tl + (cg_ + e) * 136 + tp) = cvt_pk_bf16(a0[e], a1[e]);
            __syncthreads();
#pragma unroll
            for (int q = 0; q < 2; ++q) { const int pid = q * NTHR + tid, chl = pid >> 4, tg = (pid & 15) * 8;
                const u32x4 w = *(const LAS u32x4*)(tl + chl * 136 + tg);
                *(u32x4*)(XT + (size_t)(c0 + chl) * T + tok0 + tg) = w; }
            __syncthreads();
        }
    }
}

struct NaState { float m, l; f32x4 o[4]; };
struct NaChunk { const bf16_t* kb; const bf16_t* vtb; size_t ldv; const LAS float* biasrow; int kc0; bool local; int tile;   };
__device__ __forceinline__ void na_load(const NaChunk& ch, int fr, int fq, bf16x8 (&kf)[2][2], u32x4 (&vw)[4]) {
#pragma unroll
    for (int t = 0; t < 2; ++t)
#pragma unroll
        for (int ks = 0; ks < 2; ++ks) kf[t][ks] = *(const bf16x8*)(ch.kb + (size_t)(16 * t + fr) * 512 + ks * 32 + fq * 8);
#pragma unroll
    for (int dt = 0; dt < 4; ++dt) { const bf16_t* vp = ch.vtb + (size_t)(dt * 16 + fr) * ch.ldv + 4 * fq;
        const u32x2 lo = *(const u32x2*)vp, hi = *(const u32x2*)(vp + 16); vw[dt].x = lo.x; vw[dt].y = lo.y; vw[dt].z = hi.x; vw[dt].w = hi.y; }
}
__device__ __forceinline__ void na_compute(NaState& st, const bf16x8 (&qf)[2], const bf16x8 (&kf)[2][2], const u32x4 (&vw)[4], const NaChunk& ch, int fq, int qc) {
    f32x4 s[2];
#pragma unroll
    for (int t = 0; t < 2; ++t) { s[t] = (f32x4){0.f, 0.f, 0.f, 0.f};
#pragma unroll
        for (int ks = 0; ks < 2; ++ks) s[t] = mfma16(kf[t][ks], qf[ks], s[t]); }
    if (ch.local) {
        const int c0 = min(max(qc - 8, 0), 48);
#pragma unroll
        for (int t = 0; t < 2; ++t)
#pragma unroll
            for (int j = 0; j < 4; ++j) { const int kc = ch.kc0 + 16 * t + 4 * fq + j; const bool ok = kc >= c0 && kc < c0 + 16; const int dc = min(max(kc - qc + 15, 0), 30);
                s[t][j] = ok ? s[t][j] + ch.biasrow[dc] : -INFINITY; }
    }
    float mx = fmaxf(fmaxf(fmaxf(s[0][0], s[0][1]), fmaxf(s[0][2], s[0][3])), fmaxf(fmaxf(s[1][0], s[1][1]), fmaxf(s[1][2], s[1][3])));
    mx = fmaxf(mx, __shfl_xor(mx, 16)); mx = fmaxf(mx, __shfl_xor(mx, 32));
    const float mn = fmaxf(st.m, mx), alpha = __expf(st.m - mn); st.m = mn;
    float ps = 0.f;
#pragma unroll
    for (int t = 0; t < 2; ++t)
#pragma unroll
        for (int j = 0; j < 4; ++j) { s[t][j] = __expf(s[t][j] - mn); ps += s[t][j]; }
    st.l = st.l * alpha + ps;
    u32x4 pw; pw.x = cvt_pk_bf16(s[0][0], s[0][1]); pw.y = cvt_pk_bf16(s[0][2], s[0][3]); pw.z = cvt_pk_bf16(s[1][0], s[1][1]); pw.w = cvt_pk_bf16(s[1][2], s[1][3]);
    const bf16x8 pf = as_bf16x8(pw);
#pragma unroll
    for (int dt = 0; dt < 4; ++dt) st.o[dt] = mfma16(as_bf16x8(vw[dt]), pf, st.o[dt] * alpha);
}
__device__ __forceinline__ void na_phase(const Params& p, LAS unsigned char* lds) {
    unsigned char* ws = p.ws; const bf16_t* Q0 = (const bf16_t*)(ws + O_Q0); const bf16_t* K0 = (const bf16_t*)(ws + O_K0); const bf16_t* V0T = (const bf16_t*)(ws + O_V0T);
    const bf16_t* CK = (const bf16_t*)(ws + O_CK); const bf16_t* CVT = (const bf16_t*)(ws + O_CVT); bf16_t* MIX = (bf16_t*)(ws + O_MIX); const float* nb = p.in[14];
    const int lane = threadIdx.x & 63, fr = lane & 15, fq = lane >> 4, gw = blockIdx.x * 8 + (threadIdx.x >> 6), nwv = gridDim.x * 8;
    LAS float* lnb = (LAS float*)(lds + 20480);
    for (int u = threadIdx.x; u < 8 * 465; u += NTHR) lnb[u] = nb[u];
    __syncthreads();
    { const bf16_t* H = (const bf16_t*)(ws + O_H); const bf16_t* W = (const bf16_t*)(ws + O_W0IN) + (size_t)4096 * 1024; float* DT = (float*)(ws + O_DT);
      for (int it = gw - 1024; it >= 0 && it < T / 16; it += nwv) {
          f32x4 d0 = (f32x4){0.f, 0.f, 0.f, 0.f}, d1 = d0;
#pragma unroll 8
          for (int ks = 0; ks < 32; ++ks) { const bf16x8 hf = *(const bf16x8*)(H + (size_t)(it * 16 + fr) * 1024 + ks * 32 + fq * 8);
              const bf16x8 w0 = *(const bf16x8*)(W + (size_t)fr * 1024 + ks * 32 + fq * 8), w1 = *(const bf16x8*)(W + (size_t)(16 + fr) * 1024 + ks * 32 + fq * 8);
              d0 = mfma16(w0, hf, d0); d1 = mfma16(w1, hf, d1); }
          *(f32x4*)(DT + (size_t)(it * 16 + fr) * 32 + 4 * fq) = d0; *(f32x4*)(DT + (size_t)(it * 16 + fr) * 32 + 16 + 4 * fq) = d1; } }
    const int bx = blockIdx.x, wv = threadIdx.x >> 6;
    for (int k = 0; k < 2; ++k) {
        int it;
        if (gridDim.x != 256) { it = gw * 2 + k; if (gw * 2 + k >= 3072) break; if (gw >= 512 && k == 0) { } it = (gw < 1024) ? (k ? -1 : gw) : 1024 + 2 * (gw - 1024) + k; if (it < 0) break; }
        else if (bx < 128) { if (k) break; const int q = (bx >> 3) * 8 + wv; it = ((q >> 5) << 8) | ((bx & 7) << 5) | (q & 31); }
        else { const int j = bx - 128, x = j & 7, idx = (j >> 3) * 16 + wv * 2 + k; it = 1024 + (((4 * x + (idx >> 6)) << 6) | (idx & 63)); }
        if (it >= 1024 + 2048) break;
        NaState st[2];
#pragma unroll
        for (int u = 0; u < 2; ++u) { st[u].m = -INFINITY; st[u].l = 0.f;
#pragma unroll
            for (int d = 0; d < 4; ++d) st[u].o[d] = (f32x4){0.f, 0.f, 0.f, 0.f}; }
        bf16x8 qf[2][2]; int qtok0, h, b, r = 0, qc0 = 0, NC = 8; const bool lat = it < 1024;
        if (lat) { b = it >> 8; h = (it >> 5) & 7; r = (it >> 1) & 15; qc0 = (it & 1) * 32; qtok0 = TC + b * 1024 + r * 64 + qc0 + fr; NC = 24; }
        else { const int u = it - 1024; b = u >> 6; h = (u >> 3) & 7; qtok0 = b * 256 + (u & 7) * 32 + fr; }
        const int r0 = min(max(r - 4, 0), 8);
#pragma unroll
        for (int u = 0; u < 2; ++u)
#pragma unroll
            for (int ks = 0; ks < 2; ++ks) qf[u][ks] = *(const bf16x8*)(Q0 + (size_t)(qtok0 + 16 * u) * 512 + h * 64 + ks * 32 + fq * 8);
        auto get = [&](int c) { NaChunk ch; ch.biasrow = lnb; ch.kc0 = 0; ch.local = false; ch.tile = -1;
            if (!lat) { const int ktok = b * 256 + c * 32; ch.kb = K0 + (size_t)ktok * 512 + h * 64; ch.vtb = V0T + (size_t)(h * 64) * T + ktok; ch.ldv = T; }
            else if (c < 8) { ch.kb = CK + (size_t)(b * 256 + c * 32) * 512 + h * 64; ch.vtb = CVT + (size_t)(b * 512 + h * 64) * 256 + c * 32; ch.ldv = 256; }
            else {
                const int l = c - 8, s_ = l >> 1, u = l & 1, br = r0 + s_, ct = qc0 + 16 * u, kc0 = min(min(max(ct - 8, 0), 48), 32), ktok = TC + b * 1024 + br * 64 + kc0;
                ch.kb = K0 + (size_t)ktok * 512 + h * 64; ch.vtb = V0T + (size_t)(h * 64) * T + ktok; ch.ldv = T; ch.biasrow = lnb + h * 465 + (br - r + 7) * 31; ch.kc0 = kc0; ch.local = true; ch.tile = u; }
            return ch; };
        bf16x8 kfa[2][2], kfb[2][2], kfc[2][2]; u32x4 vwa[4], vwb[4], vwc[4];
        { const NaChunk c0_ = get(0), c1_ = get(1); na_load(c0_, fr, fq, kfa, vwa); na_load(c1_, fr, fq, kfb, vwb); }
        auto step = [&](const bf16x8 (&kfx)[2][2], const u32x4 (&vwx)[4], bf16x8 (&kfy)[2][2], u32x4 (&vwy)[4], int c) {
            if (c + 2 < NC) { const NaChunk n2 = get(c + 2); na_load(n2, fr, fq, kfy, vwy); }
            const NaChunk cur = get(c);
            if (cur.tile != 1) na_compute(st[0], qf[0], kfx, vwx, cur, fq, qc0 + fr);
            if (cur.tile != 0) na_compute(st[1], qf[1], kfx, vwx, cur, fq, qc0 + 16 + fr);
        };
        for (int c = 0; c < NC; c += 3) {
            step(kfa, vwa, kfc, vwc, c);
            if (c + 1 < NC) step(kfb, vwb, kfa, vwa, c + 1);
            if (c + 2 < NC) step(kfc, vwc, kfb, vwb, c + 2);
        }
#pragma unroll
        for (int u = 0; u < 2; ++u) { float l = st[u].l; l += __shfl_xor(l, 16); l += __shfl_xor(l, 32); const float inv = 1.f / l;
#pragma unroll
            for (int dt = 0; dt < 4; ++dt) st_bf16x4(MIX + (size_t)(qtok0 + 16 * u) * 1536 + h * 64 + dt * 16 + 4 * fq, st[u].o[dt] * inv); }
    }
}

__device__ __forceinline__ LAS unsigned char* opq(LAS unsigned char* p) { asm volatile("" : "+v"(p)); return p; }
template <int DK, bool SSD, int DV, bool GPRE>
__device__ __forceinline__ void scan_item(LAS unsigned char* lds, const bf16_t* Qg, const bf16_t* Kg, int ldqk, const bf16_t* KTg, const bf16_t* VTg, int tok0, int nch, int dir,
                          const float* s0, float* sfin, int ldS, bf16_t* Y, int ldy, const float* DTp, float dtb, float aneg, const float* GPh  ) {
    constexpr int NKS = DK / 32, RS = DK * 2 + 16, TS = 144, NPT = DV / 16, NPW = NPT / 2  , NPI = NPT / 4  ;
    constexpr int OQ = 1024, OK_ = OQ + 64 * RS, OKT = GPRE ? OK_ : OK_ + 64 * RS, OVT = OKT + DK * TS, OS = OVT + DV * TS;
    static_assert(OS + DV * RS <= LDS_XB_OFF, "scan LDS budget");
    constexpr int NPQ = 64 * DK / 8 / NTHR, NPKT = DK * 8 / NTHR, NPV = DV * 8 / NTHR, C8 = DK / 8, NPK = GPRE ? 0 : NPQ;
    LAS float* le = (LAS float*)lds; LAS float* ldtv = le + 64; LAS float* ldtt = le + 128; LAS float* lE = le + 192;
    const int tid = threadIdx.x, wid = __builtin_amdgcn_readfirstlane(tid >> 6), lane = tid & 63, fr = lane & 15, fq = lane >> 4;
    const int it = wid & 3, ph = wid >> 2, i = it * 16 + fr;
    constexpr int RPQ = NTHR / C8;
    LAS unsigned char* const qb = opq(lds + OQ + i * RS + fq * 16);
    LAS unsigned char* const kb_ = opq(lds + OK_ + fr * RS + fq * 16);
    LAS unsigned char* const zb = opq(lds + OS + (NPW * ph * 16 + fr) * RS + fq * 16);
    LAS unsigned char* const ktb = opq(lds + OKT + (ph * NKS * 16 + fr) * TS + fq * 16);
    LAS unsigned char* const vyb = opq(lds + OVT + (NPW * ph * 16 + fr) * TS + fq * 8);
    LAS unsigned char* const vsb = opq(lds + OVT + (it * 16 + fr) * TS + fq * 16);
    LAS unsigned char* const stb = opq(lds + OS + (it * 16 + 4 * fq) * RS + (ph * NKS * 16 + fr) * 2);
    LAS unsigned char* const cqb = opq(lds + OQ + (tid / C8) * RS + (tid % C8) * 16);
    LAS unsigned char* const ckb = opq(lds + OK_ + (tid / C8) * RS + (tid % C8) * 16);
    LAS unsigned char* const cktb = opq(lds + OKT + (tid >> 3) * TS + (tid & 7) * 16);
    LAS unsigned char* const cvb = opq(lds + OVT + (tid >> 3) * TS + (tid & 7) * 16);
    u32x4 pf[NPQ + NPK + NPKT + NPV]; f32x4 gcur[4];
    auto issue = [&](int tokc) {
        int t_ = tid; asm volatile("" : "+v"(t_));
#pragma unroll
        for (int q = 0; q < NPQ; ++q) { const int pid = q * NTHR + t_, row = pid / C8, c8 = pid % C8;
            pf[q] = *(const u32x4*)(Qg + (size_t)(tokc + row) * ldqk + c8 * 8); if (!GPRE) pf[NPQ + q] = *(const u32x4*)(Kg + (size_t)(tokc + row) * ldqk + c8 * 8); }
#pragma unroll
        for (int q = 0; q < NPKT; ++q) { const int pid = q * NTHR + t_, n = pid >> 3, tg = pid & 7; pf[NPQ + NPK + q] = *(const u32x4*)(KTg + (size_t)n * T + tokc + tg * 8); }
#pragma unroll
        for (int q = 0; q < NPV; ++q) { const int pid = q * NTHR + t_, pr = pid >> 3, tg = pid & 7; pf[NPQ + NPK + NPKT + q] = *(const u32x4*)(VTg + (size_t)pr * T + tokc + tg * 8); }
    };
    auto issue_g = [&](int tokc) {
#pragma unroll
        for (int jt = 0; jt < 4; ++jt) if (dir ? (jt >= it) : (jt <= it)) gcur[jt] = *(const f32x4*)(GPh + ((size_t)((tokc >> 6) * 4 * 16 + it * 4 + jt) * 64 + lane) * 4);
    };
    auto commit = [&]() {
#pragma unroll
        for (int q = 0; q < NPQ; ++q) { *(LAS u32x4*)(cqb + q * RPQ * RS) = pf[q]; if (!GPRE) *(LAS u32x4*)(ckb + q * RPQ * RS) = pf[NPQ + q]; }
#pragma unroll
        for (int q = 0; q < NPKT; ++q) *(LAS u32x4*)(cktb + q * 64 * TS) = pf[NPQ + NPK + q];
#pragma unroll
        for (int q = 0; q < NPV; ++q) *(LAS u32x4*)(cvb + q * 64 * TS) = pf[NPQ + NPK + NPKT + q];
    };
    const bool oddl = fr & 1;
    LAS unsigned char* const stb2 = opq(stb + (oddl ? 2 * RS - 2 : 0));
    auto put_state = [&](const f32x4 (&sacc)[NPI][NKS]) {
#pragma unroll
        for (int pi = 0; pi < NPI; ++pi)
#pragma unroll
            for (int q = 0; q < NKS; ++q) { const f32x4 a = sacc[pi][q];
                const float s0_ = oddl ? a[0] : a[2], s1_ = oddl ? a[1] : a[3];
                const float r0_ = __int_as_float(__builtin_amdgcn_update_dpp(0, __float_as_int(s0_), 0xB1, 0xF, 0xF, true));
                const float r1_ = __int_as_float(__builtin_amdgcn_update_dpp(0, __float_as_int(s1_), 0xB1, 0xF, 0xF, true));
                const unsigned w0 = oddl ? cvt_pk_bf16(r0_, a[2]) : cvt_pk_bf16(a[0], r0_), w1 = oddl ? cvt_pk_bf16(r1_, a[3]) : cvt_pk_bf16(a[1], r1_);
                *(LAS unsigned*)(stb2 + (pi * 64) * RS + q * 32) = w0; *(LAS unsigned*)(stb2 + (pi * 64 + 1) * RS + q * 32) = w1; }
    };
    issue(tok0 + (dir ? nch - 1 : 0) * 64);
    float dtraw = 0.f;
    if (SSD && wid == 0) dtraw = DTp[(size_t)(tok0 + (dir ? nch - 1 : 0) * 64 + lane) * 32];
    f32x4 sacc[NPI][NKS];
#pragma unroll
    for (int pi = 0; pi < NPI; ++pi)
#pragma unroll
        for (int q = 0; q < NKS; ++q) { const int nt = ph * NKS + q, ptl = it + 4 * pi;
            sacc[pi][q] = s0 ? *(const f32x4*)(s0 + (size_t)(nt * 16 + fr) * ldS + ptl * 16 + 4 * fq) : (f32x4){0.f, 0.f, 0.f, 0.f}; }
    put_state(sacc);
#pragma unroll
    for (int jt = 0; jt < 4; ++jt) gcur[jt] = (f32x4){0.f, 0.f, 0.f, 0.f};
    if (GPRE) issue_g(tok0 + (dir ? nch - 1 : 0) * 64);
    commit();
    for (int cc = 0; cc < nch; ++cc) {
        const int c = dir ? nch - 1 - cc : cc, tokc = tok0 + c * 64;
        const bool has_next = cc + 1 < nch; const int tokn = tok0 + (dir ? c - 1 : c + 1) * 64;
        if (!GPRE && has_next) issue(tokn);
        if (wid == 0) {
            float dt = 1.f, a = aneg;
            if (SSD) { dt = softplusf(dtraw + dtb); a = dt * aneg; if (has_next) dtraw = DTp[(size_t)(tokn + lane) * 32]; }
            float cs = a;
#pragma unroll
            for (int o = 1; o < 64; o <<= 1) { const float v = __shfl_up(cs, o); if (lane >= o) cs += v; }
            const float tot = __shfl(cs, 63), e = dir ? (tot - cs + a) : cs;
            le[lane] = e; ldtv[lane] = dt; ldtt[lane] = dt * __expf(tot - e); if (lane == 0) lE[0] = tot;
        }
        __syncthreads();
        const float ei = le[i];
        bf16x8 qf[NKS];
        if (!GPRE) {
#pragma unroll
            for (int ks = 0; ks < NKS; ++ks) qf[ks] = *(const LAS bf16x8*)(qb + ks * 64);
        }
        unsigned pw[2][4];
#pragma unroll
        for (int jt = 0; jt < 4; ++jt) {
            const bool tv = dir ? (jt >= it) : (jt <= it);
            f32x4 g = (f32x4){0.f, 0.f, 0.f, 0.f};
            if (tv) {
                if (GPRE) g = gcur[jt];
                else {
#pragma unroll
                    for (int ks = 0; ks < NKS; ++ks) { const bf16x8 kf = *(const LAS bf16x8*)(kb_ + jt * 16 * RS + ks * 64); g = mfma16(kf, qf[ks], g); }
                }
                const f32x4 ej = *(const LAS f32x4*)(le + jt * 16 + 4 * fq);
#pragma unroll
                for (int j = 0; j < 4; ++j) { const int jj = jt * 16 + 4 * fq + j; const bool ok = dir ? (jj >= i) : (jj <= i); g[j] = ok ? g[j] * __expf(ei - ej[j]) : 0.f; }
            }
            pw[jt >> 1][(jt & 1) * 2] = cvt_pk_bf16(g[0], g[1]); pw[jt >> 1][(jt & 1) * 2 + 1] = cvt_pk_bf16(g[2], g[3]);
        }
        if (GPRE && has_next) { issue_g(tokn); issue(tokn); }
        const float ex = __expf(ei);
        f32x4 ya[NPW], za[NPW];
#pragma unroll
        for (int pp = 0; pp < NPW; ++pp) {
            const int pt = NPW * ph + pp; ya[pp] = (f32x4){0.f, 0.f, 0.f, 0.f}; za[pp] = (f32x4){0.f, 0.f, 0.f, 0.f};
#pragma unroll
            for (int k2 = 0; k2 < 2; ++k2) {
                const bool skip = dir ? (2 * k2 + 1 < it) : (2 * k2 > it);
                if (!skip) {
                    const LAS unsigned char* vp = vyb + pp * 16 * TS + k2 * 64;
                    u32x2 lo = *(const LAS u32x2*)vp, hi = *(const LAS u32x2*)(vp + 32);
                    if (SSD) { const int j0 = 32 * k2 + 4 * fq; const f32x4 d0 = *(const LAS f32x4*)(ldtv + j0), d1 = *(const LAS f32x4*)(ldtv + j0 + 16);
                        lo.x = cvt_pk_bf16(bf_lo(lo.x) * d0[0], bf_hi(lo.x) * d0[1]); lo.y = cvt_pk_bf16(bf_lo(lo.y) * d0[2], bf_hi(lo.y) * d0[3]);
                        hi.x = cvt_pk_bf16(bf_lo(hi.x) * d1[0], bf_hi(hi.x) * d1[1]); hi.y = cvt_pk_bf16(bf_lo(hi.y) * d1[2], bf_hi(hi.y) * d1[3]); }
                    u32x4 vw; vw.x = lo.x; vw.y = lo.y; vw.z = hi.x; vw.w = hi.y;
                    u32x4 pfr; pfr.x = pw[k2][0]; pfr.y = pw[k2][1]; pfr.z = pw[k2][2]; pfr.w = pw[k2][3];
                    ya[pp] = mfma16(as_bf16x8(vw), as_bf16x8(pfr), ya[pp]);
                }
            }
        }
#pragma unroll
        for (int ks = 0; ks < NKS; ++ks) {
            const bf16x8 qk = GPRE ? *(const LAS bf16x8*)(qb + ks * 64) : qf[ks];
#pragma unroll
            for (int pp = 0; pp < NPW; ++pp) { const bf16x8 sf = *(const LAS bf16x8*)(zb + pp * 16 * RS + ks * 64); za[pp] = mfma16(sf, qk, za[pp]); }
        }
#pragma unroll
        for (int pp = 0; pp < NPW; ++pp) st_bf16x4(Y + (size_t)(tokc + i) * ldy + (NPW * ph + pp) * 16 + 4 * fq, ya[pp] + za[pp] * ex);
        {
            const float eE = __expf(lE[0]);
            bf16x8 vs[NPI][2];
#pragma unroll
            for (int pi = 0; pi < NPI; ++pi)
#pragma unroll
                for (int k2 = 0; k2 < 2; ++k2) { const u32x4 w = *(const LAS u32x4*)(vsb + pi * 64 * TS + k2 * 64); const int j0 = k2 * 32 + fq * 8;
                    const f32x4 t0 = *(const LAS f32x4*)(ldtt + j0), t1 = *(const LAS f32x4*)(ldtt + j0 + 4); u32x4 o;
                    o.x = cvt_pk_bf16(bf_lo(w.x) * t0[0], bf_hi(w.x) * t0[1]); o.y = cvt_pk_bf16(bf_lo(w.y) * t0[2], bf_hi(w.y) * t0[3]);
                    o.z = cvt_pk_bf16(bf_lo(w.z) * t1[0], bf_hi(w.z) * t1[1]); o.w = cvt_pk_bf16(bf_lo(w.w) * t1[2], bf_hi(w.w) * t1[3]);
                    vs[pi][k2] = as_bf16x8(o); }
#pragma unroll
            for (int q = 0; q < NKS; ++q) { const int nt = ph * NKS + q;
                bf16x8 kt[2];
#pragma unroll
                for (int k2 = 0; k2 < 2; ++k2) kt[k2] = *(const LAS bf16x8*)(ktb + q * 16 * TS + k2 * 64);
#pragma unroll
                for (int pi = 0; pi < NPI; ++pi) { sacc[pi][q] = sacc[pi][q] * eE;
#pragma unroll
                    for (int k2 = 0; k2 < 2; ++k2) sacc[pi][q] = mfma16(vs[pi][k2], kt[k2], sacc[pi][q]); }
                if (GPRE && (q & 1)) __builtin_amdgcn_sched_barrier(0);
            }
        }
        __syncthreads();
        if (has_next) {
            put_state(sacc);
            commit();
        }
    }
    if (sfin) {
#pragma unroll
        for (int pi = 0; pi < NPI; ++pi)
#pragma unroll
            for (int q = 0; q < NKS; ++q) { const int nt = ph * NKS + q; *(f32x4*)(sfin + (size_t)(nt * 16 + fr) * ldS + (it + 4 * pi) * 16 + 4 * fq) = sacc[pi][q]; }
    }
}
__device__ __forceinline__ void retg_item(const bf16_t* QR, const bf16_t* KR, float* GP, int c, int h, int it, int lane) {
    const int fr = lane & 15, fq = lane >> 4, tokc = c * 64;
    bf16x8 qf[8];
#pragma unroll
    for (int ks = 0; ks < 8; ++ks) qf[ks] = *(const bf16x8*)(QR + (size_t)(tokc + it * 16 + fr) * 1024 + h * 256 + ks * 32 + fq * 8);
#pragma unroll
    for (int jt = 0; jt < 4; ++jt) { f32x4 g = (f32x4){0.f, 0.f, 0.f, 0.f};
#pragma unroll
        for (int ks = 0; ks < 8; ++ks) { const bf16x8 kf = *(const bf16x8*)(KR + (size_t)(tokc + jt * 16 + fr) * 1024 + h * 256 + ks * 32 + fq * 8); g = mfma16(kf, qf[ks], g); }
        *(f32x4*)(GP + ((size_t)(((c * 4 + h) * 4 + it) * 4 + jt) * 64 + lane) * 4) = g; }
}
__device__ __forceinline__ void in1_phase(const Params& p, LAS unsigned char* lds, const EpiIn1& e) {
    unsigned char* ws = p.ws; const bf16_t* H = (const bf16_t*)(ws + O_H); const bf16_t* W = (const bf16_t*)(ws + O_W1IN);
    const int bx = (int)blockIdx.x, G = (int)gridDim.x; const bool fused = G == 256;
    for (int k = 0;; ++k) {
        int pm, pn; bool ok;
        if (fused) { ok = k < 3;
            if (bx < 192) { pm = bx >> 2; pn = 4 * k + (bx & 3); }
            else { const int t = (bx - 192) * 3 + k; pm = t >> 2; pn = 12 + (t & 3); } }
        else ok = tile_of(k * G + bx, T / BM, 16, pm, pn);
        if (!ok) break;
        gemm_tile(lds, H, W, 1024, pm * BM, pn * BM, e);
        if (fused && bx < 192 && k == 1) {
            const bf16_t* QR = (const bf16_t*)(ws + O_QR); const bf16_t* KR = (const bf16_t*)(ws + O_KR); float* GP = (float*)(ws + O_GP);
            const int wv = threadIdx.x >> 6, lane = threadIdx.x & 63;
            for (int u = wv; u < 16; u += 8) retg_item(QR, KR, GP, pm * 4 + (u >> 2), bx & 3, u & 3, lane);
        }
    }
}
__device__ __forceinline__ void retg_phase(const Params& p) {
    unsigned char* ws = p.ws; const bf16_t* QR = (const bf16_t*)(ws + O_QR); const bf16_t* KR = (const bf16_t*)(ws + O_KR); float* GP = (float*)(ws + O_GP);
    const int lane = threadIdx.x & 63, gw = blockIdx.x * 8 + (threadIdx.x >> 6), nwv = gridDim.x * 8;
    for (int idx = gw; idx < 192 * 4 * 4; idx += nwv) retg_item(QR, KR, GP, idx >> 4, (idx >> 2) & 3, idx & 3, lane);
}
__device__ __forceinline__ int next_item(unsigned* ctr, LAS unsigned char* lds) {
    LAS int* slot = (LAS int*)(lds + 896);
    if (threadIdx.x == 0) slot[0] = (int)atomicAdd(ctr, 1u);
    __syncthreads();
    const int v = slot[0];
    __syncthreads();
    return v;
}
__device__ __forceinline__ void ssd_phase(const Params& p, LAS unsigned char* lds, int rep) {
    unsigned char* ws = p.ws; unsigned* ctr = (unsigned*)(ws + O_CTL) + 0 + 2 * rep;
    const bf16_t* XC = (const bf16_t*)(ws + O_XC); const bf16_t* XT = (const bf16_t*)(ws + O_XT); bf16_t* YS = (bf16_t*)(ws + O_YS); const float* DT = (const float*)(ws + O_DT);
    for (;;) {
        const int it = next_item(ctr, lds); if (it >= 128 + 1024) break;
        int b, dir, h, tok0, nch; const float* s0 = nullptr; float* sfin = nullptr;
        if (it < 128) { b = it >> 5; dir = (it >> 4) & 1; h = it & 15; tok0 = TC + b * 1024; nch = 16; s0 = p.in[4] + (size_t)((b * 2 + dir) * 16 + h) * 128 * 64; }
        else { const int u = it - 128; b = u >> 5; dir = (u >> 4) & 1; h = u & 15; tok0 = b * 256; nch = 4; sfin = p.out + OUT_SSD + (size_t)((b * 2 + dir) * 16 + h) * 128 * 64; }
        const int g = h >> 3;
        scan_item<128, true, 64, false>(lds, XC + 1280 + g * 128, XC + 1024 + g * 128, 1536, XT + (size_t)(1024 + g * 128) * T, XT + (size_t)(h * 64) * T, tok0, nch, dir, s0, sfin, 64,
                             YS + (size_t)dir * T * 1024 + h * 64, 1024, DT + dir * 16 + h, p.in[18][dir * 16 + h], -__expf(p.in[17][dir * 16 + h]), nullptr);
    }
}
__device__ __forceinline__ void ret_phase(const Params& p, LAS unsigned char* lds, int rep) {
    unsigned char* ws = p.ws; unsigned* ctr = (unsigned*)(ws + O_CTL) + 1 + 2 * rep;
    const bf16_t* QR = (const bf16_t*)(ws + O_QR); const bf16_t* KR = (const bf16_t*)(ws + O_KR); const bf16_t* KRT = (const bf16_t*)(ws + O_KRT); const bf16_t* VRT = (const bf16_t*)(ws + O_VRT);
    bf16_t* YR = (bf16_t*)(ws + O_YR); const float* GP = (const float*)(ws + O_GP);
    int first_tile = 0;
    for (;;) {
        const int it = next_item(ctr, lds); if (it >= 128 + 1024) { first_tile = it; break; }
        int b, dir, h, sl, tok0, nch; const float* s0 = nullptr; float* sfin = nullptr;
        if (it < 128) { b = it >> 5; dir = (it >> 4) & 1; h = (it >> 2) & 3; sl = it & 3; tok0 = TC + b * 1024; nch = 16; s0 = p.in[5] + (size_t)((b * 2 + dir) * 4 + h) * 256 * 512 + sl * 128; }
        else { const int u = it - 128; b = u >> 5; dir = (u >> 4) & 1; h = (u >> 2) & 3; sl = u & 3; tok0 = b * 256; nch = 4; sfin = p.out + OUT_RET + (size_t)((b * 2 + dir) * 4 + h) * 256 * 512 + sl * 128; }
        const float x = p.in[30][dir * 4 + h]; const float lg = -softplusf(-x);
        scan_item<256, false, 128, true>(lds, QR + h * 256, KR + h * 256, 1024, KRT + (size_t)(h * 256) * T, VRT + (size_t)(h * 512 + sl * 128) * T, tok0, nch, dir, s0, sfin, 512,
                              YR + (size_t)dir * T * 2048 + h * 512 + sl * 128, 2048, nullptr, 0.f, lg, GP + (size_t)h * 16 * 256);
    }
    { const EpiIn1 e{(bf16_t*)(ws + O_QR), (bf16_t*)(ws + O_KR), (bf16_t*)(ws + O_KRT), (bf16_t*)(ws + O_VRT), (bf16_t*)(ws + O_GR)};
      for (int it = first_tile; it < 128 + 1024 + 384; it = next_item(ctr, lds)) { const int t = it - (128 + 1024);
          gemm_tile(lds, (const bf16_t*)(ws + O_H), (const bf16_t*)(ws + O_W1IN), 1024, (t >> 3) * 256, 4096 + (t & 7) * 256, e); } }
}

__device__ __forceinline__ void ssd_gate_phase(const Params& p) {
    unsigned char* ws = p.ws; const bf16_t* YS = (const bf16_t*)(ws + O_YS); const bf16_t* XC = (const bf16_t*)(ws + O_XC); const bf16_t* Z = (const bf16_t*)(ws + O_Z); bf16_t* MIX = (bf16_t*)(ws + O_MIX);
    const float* dsk = p.in[19]; const float* nw = p.in[20];
    const int lane = threadIdx.x & 63, gw = blockIdx.x * 8 + (threadIdx.x >> 6), nwv = gridDim.x * 8;
    for (int it = gw; it < T * 2; it += nwv) {
        const int tok = it >> 1, g = it & 1, ch = g * 512 + lane * 8;
        float a[8], b[8], x[8], z[8];
        unpack8(*(const u32x4*)(YS + (size_t)tok * 1024 + ch), a); unpack8(*(const u32x4*)(YS + (size_t)(T + tok) * 1024 + ch), b);
        unpack8(*(const u32x4*)(XC + (size_t)tok * 1536 + ch), x); unpack8(*(const u32x4*)(Z + (size_t)tok * 1024 + ch), z);
        const float d = dsk[ch >> 6]; float ss = 0.f;
#pragma unroll
        for (int e = 0; e < 8; ++e) { a[e] = (a[e] + b[e] + d * x[e]) * siluf(z[e]); ss += a[e] * a[e]; }
        ss = wave_sum(ss); const float rstd = rsqrtf(ss * (1.f / 512.f) + 1e-6f);
        const f32x4 w0 = *(const f32x4*)(nw + ch), w1 = *(const f32x4*)(nw + ch + 4);
        u32x4 o; o.x = cvt_pk_bf16(a[0] * rstd * w0[0], a[1] * rstd * w0[1]); o.y = cvt_pk_bf16(a[2] * rstd * w0[2], a[3] * rstd * w0[3]);
        o.z = cvt_pk_bf16(a[4] * rstd * w1[0], a[5] * rstd * w1[1]); o.w = cvt_pk_bf16(a[6] * rstd * w1[2], a[7] * rstd * w1[3]);
        *(u32x4*)(MIX + (size_t)tok * 1536 + 512 + ch) = o;
    }
}
__device__ __forceinline__ void ret_gate_phase(const Params& p) {
    unsigned char* ws = p.ws; const bf16_t* YR = (const bf16_t*)(ws + O_YR); const bf16_t* GR = (const bf16_t*)(ws + O_GR); bf16_t* RG = (bf16_t*)(ws + O_RG);
    const float* nw = p.in[31];
    const int lane = threadIdx.x & 63, gw = blockIdx.x * 8 + (threadIdx.x >> 6), nwv = gridDim.x * 8;
    for (int it = gw; it < T * 4; it += nwv) {
        const int tok = it >> 2, h = it & 3, ch = h * 512 + lane * 8;
        float a[8], b[8], gt[8];
        unpack8(*(const u32x4*)(YR + (size_t)tok * 2048 + ch), a); unpack8(*(const u32x4*)(YR + (size_t)(T + tok) * 2048 + ch), b); unpack8(*(const u32x4*)(GR + (size_t)tok * 2048 + ch), gt);
        float ss = 0.f;
#pragma unroll
        for (int e = 0; e < 8; ++e) { a[e] += b[e]; ss += a[e] * a[e]; }
        ss = wave_sum(ss); const float rstd = rsqrtf(ss * (1.f / 512.f) + 1e-6f);
        const f32x4 w0 = *(const f32x4*)(nw + ch), w1 = *(const f32x4*)(nw + ch + 4);
        float o[8];
#pragma unroll
        for (int e = 0; e < 8; ++e) o[e] = a[e] * rstd * (e < 4 ? w0[e] : w1[e - 4]) * siluf(gt[e]);
        u32x4 ow; ow.x = cvt_pk_bf16(o[0], o[1]); ow.y = cvt_pk_bf16(o[2], o[3]); ow.z = cvt_pk_bf16(o[4], o[5]); ow.w = cvt_pk_bf16(o[6], o[7]);
        *(u32x4*)(RG + (size_t)tok * 2048 + ch) = ow;
    }
}

#define XB_TMO      128
#define XB_XCNT(j)  (256  + 64 * (j))
#define XB_XSUB(j)  (1280 + 64 * (j))
#define XB_XGEN(j)  (2304 + 64 * (j))
#define XB_TOP      3328
#define XB_TOPGEN   3392
#define XCD_BAR_WORDS 3456
#define XB_SPIN_CAP (1u << 18)
__device__ __forceinline__ unsigned xb_ld(unsigned* p)              { return __hip_atomic_load(p, __ATOMIC_RELAXED, __HIP_MEMORY_SCOPE_AGENT); }
__device__ __forceinline__ unsigned xb_add(unsigned* p, unsigned v) { return __hip_atomic_fetch_add(p, v, __ATOMIC_RELAXED, __HIP_MEMORY_SCOPE_AGENT); }
__device__ __forceinline__ unsigned xb_xcc_id() { return (unsigned)__builtin_amdgcn_s_getreg((3 << 11) | 20) & 0xFu; }
#define XB_SPIN(cond, bar) do { unsigned _sp = 0; while (cond) { __builtin_amdgcn_s_sleep(1); \
    if ((++_sp & 255u) == 0u) { if (xb_ld(&(bar)[XB_TMO])) break; if (_sp > XB_SPIN_CAP) { atomicAdd(&(bar)[XB_TMO], 1u); break; } } } } while (0)
struct XcdBarrier { unsigned* bar; unsigned x; volatile LAS unsigned* st; };
__device__ __forceinline__ XcdBarrier xcd_barrier_post(unsigned* bar, volatile LAS unsigned* st) {
    XcdBarrier b; b.bar = bar; b.x = xb_xcc_id(); b.st = st;
    if (threadIdx.x == 0) (void)xb_add(&bar[XB_XCNT(b.x)], 1u);
    return b;
}
__device__ __forceinline__ void xcd_barrier_complete(unsigned* bar, unsigned x, unsigned& nloc, unsigned& nx) {
    const unsigned G = gridDim.x * gridDim.y * gridDim.z;
    unsigned sum, cnt, mine, sp = 0u;
    for (;;) {
        sum = 0u; cnt = 0u; mine = 0u;
#pragma unroll
        for (unsigned j = 0; j < 16; ++j) { const unsigned c = xb_ld(&bar[XB_XCNT(j)]); sum += c; cnt += (c > 0u) ? 1u : 0u; mine = (j == x) ? c : mine; }
        if (sum == G) break;
        __builtin_amdgcn_s_sleep(1);
        if ((++sp & 255u) == 0u) { if (xb_ld(&bar[XB_TMO])) break; if (sp > XB_SPIN_CAP) { atomicAdd(&bar[XB_TMO], 1u); break; } }
    }
    nloc = mine > 0u ? mine : 1u; nx = cnt > 0u ? cnt : 1u;
}
__device__ __forceinline__ void xcd_barrier(const XcdBarrier& b) {
    asm volatile("s_waitcnt vmcnt(0)" ::: "memory");
    __syncthreads();
    if (threadIdx.x == 0) {
        unsigned* bar = b.bar;
        __builtin_amdgcn_s_waitcnt(0);
        unsigned nloc = b.st[0], nx = b.st[1];
        if (nloc == 0u) { xcd_barrier_complete(bar, b.x, nloc, nx); b.st[0] = nloc; b.st[1] = nx; }
        const unsigned old = xb_add(&bar[XB_XSUB(b.x)], 1u);
        const unsigned gen = old / nloc;
        if (old + 1u == (gen + 1u) * nloc) {
            __builtin_amdgcn_fence(__ATOMIC_RELEASE, "agent");
            asm volatile("s_waitcnt vmcnt(0)" ::: "memory");
            const unsigned og = xb_add(&bar[XB_TOP], 1u);
            const unsigned tg = og / nx;
            if (og + 1u == (tg + 1u) * nx) xb_add(&bar[XB_TOPGEN], 1u);
            else XB_SPIN(xb_ld(&bar[XB_TOPGEN]) == tg, bar);
            __builtin_amdgcn_fence(__ATOMIC_ACQUIRE, "agent");
            xb_add(&bar[XB_XGEN(b.x)], 1u);
            asm volatile("s_waitcnt vmcnt(0)" ::: "memory");
        } else {
            XB_SPIN(xb_ld(&bar[XB_XGEN(b.x)]) == gen, bar);
            __builtin_amdgcn_fence(__ATOMIC_ACQUIRE, "agent");
            asm volatile("s_waitcnt vmcnt(0)" ::: "memory");
        }
    }
    __syncthreads();
}

constexpr int N_PHASES = 19;
__global__ void __launch_bounds__(NTHR) fwd_megakernel(Params p_arg) {
    const Params& p = *(const Params*)__builtin_amdgcn_kernarg_segment_ptr();
    extern __shared__ __attribute__((aligned(16))) unsigned char lds_raw[];
    LAS unsigned char* lds = (LAS unsigned char*)lds_raw;
    cg::grid_group grid = cg::this_grid();
    if (threadIdx.x < 4) ((LAS unsigned*)(lds + LDS_XB_OFF))[threadIdx.x] = 0u;
    __syncthreads();
    (void)xcd_barrier_post((unsigned*)(p.ws + O_CTL) + 256, (volatile LAS unsigned*)(lds + LDS_XB_OFF));
    unsigned char* ws = p.ws;
    float* MOD = (float*)(ws + O_MOD); bf16_t* H = (bf16_t*)(ws + O_H); float* XA = (float*)(ws + O_XA);
#ifdef ONLY_PHASE
#define PH_ON(k) ((k) == ONLY_PHASE)
#else
#define PH_ON(k) (p.ph_lo <= (k) && (k) < p.ph_hi)
#endif
#ifndef PROBE_MASK
#define PROBE_MASK 0
#endif
#define PH_BEGIN(k) if (PH_ON(k)) { for (int rep = 0; rep <= ((PROBE_MASK >> (k)) & 1); ++rep) {
#define PH_END(k) } } if (p.ph_lo <= (k) && (k) + 1 < p.ph_hi) { if ((k) == 0 && p.ph_lo < 0) grid.sync(); else { XcdBarrier xb_; xb_.bar = (unsigned*)(p.ws + O_CTL) + 256; xb_.x = xb_xcc_id(); xb_.st = (volatile LAS unsigned*)(lds + LDS_XB_OFF); xcd_barrier(xb_); } }
    PH_BEGIN(0) prep_phase(p, lds, 0, (int)blockIdx.x, (int)gridDim.x);
        if (gridDim.x <= 192) { prep_phase(p, lds, 1, (int)blockIdx.x, (int)gridDim.x); prep_phase(p, lds, 2, (int)blockIdx.x, (int)gridDim.x); } PH_END(0)
    PH_BEGIN(1) norm_phase(p.in[0], p.in[1], p.in[8], MOD, 0, 1024, H, nullptr); PH_END(1)
    PH_BEGIN(2) EpiIn0 e{(bf16_t*)(ws + O_Q0), (bf16_t*)(ws + O_K0), (bf16_t*)(ws + O_V0T), (bf16_t*)(ws + O_Z), (bf16_t*)(ws + O_XBC), (float*)(ws + O_DT), p.out + OUT_K, p.out + OUT_V};
        gemm_phase(lds, H, (const bf16_t*)(ws + O_W0IN), 4096, 1024, e); PH_END(2)
    PH_BEGIN(3) conv_phase(p, lds); na_phase(p, lds); PH_END(3)
    PH_BEGIN(4) ssd_phase(p, lds, rep); PH_END(4)
    PH_BEGIN(5) ssd_gate_phase(p); PH_END(5)
    PH_BEGIN(6) EpiRes e{p.in[0], p.in[1], XA, MOD + 2048}; gemm_phase(lds, (const bf16_t*)(ws + O_MIX), (const bf16_t*)(ws + O_W0OUT), 1024, 1536, e, &p, gridDim.x > 192 ? 1 : 0); PH_END(6)
    PH_BEGIN(7) norm_phase(XA, XA + (size_t)TC * 1024, p.in[9], MOD, 3072, 4096, H, nullptr); PH_END(7)
    PH_BEGIN(8) EpiSwiglu e{(bf16_t*)(ws + O_HID)}; gemm_phase(lds, H, (const bf16_t*)(ws + O_W0UP), 5376, 1024, e); PH_END(8)
    PH_BEGIN(9) EpiRes e{XA, XA + (size_t)TC * 1024, XA, MOD + 5120}; down_phase(p, lds, H, (const bf16_t*)(ws + O_W0UP), (const bf16_t*)(ws + O_W0DN), e, (unsigned*)(ws + O_CTL) + 3712, 2); PH_END(9)
    PH_BEGIN(10) norm_phase(XA, XA + (size_t)TC * 1024, p.in[24], MOD + 5 * 6144, 0, 1024, H, nullptr); PH_END(10)
    PH_BEGIN(11) EpiIn1 e{(bf16_t*)(ws + O_QR), (bf16_t*)(ws + O_KR), (bf16_t*)(ws + O_KRT), (bf16_t*)(ws + O_VRT), (bf16_t*)(ws + O_GR)};
        in1_phase(p, lds, e);
        if (gridDim.x != 256) { XcdBarrier xb_; xb_.bar = (unsigned*)(p.ws + O_CTL) + 256; xb_.x = xb_xcc_id(); xb_.st = (volatile LAS unsigned*)(lds + LDS_XB_OFF); xcd_barrier(xb_); retg_phase(p); } PH_END(11)
    PH_BEGIN(12) ret_phase(p, lds, rep); PH_END(12)
    PH_BEGIN(13) ret_gate_phase(p); PH_END(13)
    PH_BEGIN(14) EpiRes e{XA, XA + (size_t)TC * 1024, XA, MOD + 5 * 6144 + 2048}; gemm_phase(lds, (const bf16_t*)(ws + O_RG), (const bf16_t*)(ws + O_W1OUT), 1024, 2048, e); PH_END(14)
    PH_BEGIN(15) norm_phase(XA, XA + (size_t)TC * 1024, p.in[25], MOD + 5 * 6144, 3072, 4096, H, nullptr); PH_END(15)
    PH_BEGIN(16) EpiSwiglu e{(bf16_t*)(ws + O_HID)}; gemm_phase(lds, H, (const bf16_t*)(ws + O_W1UP), 5376, 1024, e); PH_END(16)
    PH_BEGIN(17) EpiRes e{XA, XA + (size_t)TC * 1024, XA, MOD + 5 * 6144 + 5120}; down_phase(p, lds, H, (const bf16_t*)(ws + O_W1UP), (const bf16_t*)(ws + O_W1DN), e, (unsigned*)(ws + O_CTL) + 3712 + 64, 0); PH_END(17)
    PH_BEGIN(18) norm_phase(XA, XA + (size_t)TC * 1024, p.in[35], nullptr, 0, 0, nullptr, p.out + OUT_Y); PH_END(18)
}

extern "C" void kernel_launch(void* const* d_in, const int* in_sizes, int n_in, void* d_out, int out_size, void* d_ws, size_t ws_size, hipStream_t stream) {
    static int grid_blocks = 0;
    if (grid_blocks == 0) {
        if (n_in != 36 || ws_size < WS_END) { fprintf(stderr, "kernel_launch: unexpected n_in %d / ws %zu (need %zu)\n", n_in, ws_size, (size_t)WS_END); grid_blocks = -1; return; }
        int dev = 0, cus = 0, per_cu = 0;
        hipGetDevice(&dev); hipDeviceGetAttribute(&cus, hipDeviceAttributeMultiprocessorCount, dev);
        if (hipFuncSetAttribute((const void*)fwd_megakernel, hipFuncAttributeMaxDynamicSharedMemorySize, LDS_BYTES) != hipSuccess) { fprintf(stderr, "kernel_launch: hipFuncSetAttribute failed\n"); grid_blocks = -1; return; }
        if (hipOccupancyMaxActiveBlocksPerMultiprocessor(&per_cu, (const void*)fwd_megakernel, NTHR, LDS_BYTES) != hipSuccess || per_cu < 1) { fprintf(stderr, "kernel_launch: occupancy query failed (%d)\n", per_cu); grid_blocks = -1; return; }
        grid_blocks = cus * per_cu;
        if (grid_blocks != 256) { fprintf(stderr, "kernel_launch: built for 256 co-resident workgroups (MI355X: 256 CUs x 1), got %d\n", grid_blocks); grid_blocks = -1; return; }
    }
    if (grid_blocks < 0) return;
    hipMemsetAsync((char*)d_ws + O_CTL, 0, 16384, stream);
    Params p{};
    for (int i = 0; i < 36; ++i) p.in[i] = (const float*)d_in[i];
    p.out = (float*)d_out; p.ws = (unsigned char*)d_ws;
#if N_SPLIT
    for (int ph = 0; ph < N_PHASES; ++ph) { p.ph_lo = ph; p.ph_hi = ph + 1; void* args[] = {&p};
        hipError_t e = hipLaunchCooperativeKernel((void*)fwd_megakernel, dim3(grid_blocks), dim3(NTHR), args, LDS_BYTES, stream);
        if (e != hipSuccess) { fprintf(stderr, "launch failed: %s\n", hipGetErrorString(e)); break; } }
#else
    p.ph_lo = 0; p.ph_hi = N_PHASES; void* args[] = {&p};
    hipError_t e = hipLaunchCooperativeKernel((void*)fwd_megakernel, dim3(grid_blocks), dim3(NTHR), args, LDS_BYTES, stream);
    if (e != hipSuccess) fprintf(stderr, "cooperative launch failed: %s (grid %d)\n", hipGetErrorString(e), grid_blocks);
#endif
}
```

```cpp
#include <hip/hip_runtime.h>
#include <hip/hip_cooperative_groups.h>
#include <cstdio>
#include <cstdint>
namespace cg = cooperative_groups;

#ifndef N_SPLIT
#define N_SPLIT 0
#endif

#define LAS __attribute__((address_space(3)))
typedef unsigned short bf16_t;
typedef short bf16x8 __attribute__((ext_vector_type(8)));
typedef float f32x4 __attribute__((ext_vector_type(4)));
typedef unsigned u32x4 __attribute__((ext_vector_type(4)));
typedef unsigned u32x2 __attribute__((ext_vector_type(2)));

constexpr int T = 12288, TC = 8192, DM = 1024;
constexpr int NTHR = 512;
constexpr int LDS_BYTES = 163840;
constexpr int LDS_XB_OFF = LDS_BYTES - 16;
constexpr int FFN = 2816;

constexpr size_t al256(size_t x) { return (x + 255) & ~(size_t)255; }
constexpr size_t O_CTL   = 0;
constexpr size_t O_MOD   = 16384;
constexpr size_t O_W0IN  = al256(O_MOD + 2 * 5 * 6144 * 4);
constexpr size_t O_W0OUT = O_W0IN + (size_t)4352 * 1024 * 2;
constexpr size_t O_W0UP  = O_W0OUT + (size_t)1024 * 1536 * 2;
constexpr size_t O_W0DN  = O_W0UP + (size_t)5632 * 1024 * 2;
constexpr size_t O_W1IN  = O_W0DN + (size_t)1024 * 2816 * 2;
constexpr size_t O_W1OUT = O_W1IN + (size_t)6144 * 1024 * 2;
constexpr size_t O_W1UP  = O_W1OUT + (size_t)1024 * 2048 * 2;
constexpr size_t O_W1DN  = O_W1UP + (size_t)5632 * 1024 * 2;
constexpr size_t O_CK    = O_W1DN + (size_t)1024 * 2816 * 2;
constexpr size_t O_CVT   = O_CK + (size_t)4 * 256 * 512 * 2;
constexpr size_t O_H     = O_CVT + (size_t)4 * 512 * 256 * 2;
constexpr size_t O_XA    = O_H + (size_t)T * 1024 * 2;
constexpr size_t O_Q0    = O_XA + (size_t)T * 1024 * 4;
constexpr size_t O_K0    = O_Q0 + (size_t)T * 512 * 2;
constexpr size_t O_V0T   = O_K0 + (size_t)T * 512 * 2;
constexpr size_t O_Z     = O_V0T + (size_t)T * 512 * 2;
constexpr size_t O_XBC   = O_Z + (size_t)T * 1024 * 2;
constexpr size_t O_DT    = O_XBC + (size_t)T * 1536 * 2;
constexpr size_t O_XC    = O_DT + (size_t)T * 32 * 4;
constexpr size_t O_XT    = O_XC + (size_t)T * 1536 * 2;
constexpr size_t O_YS    = O_XT + (size_t)1280 * T * 2;
constexpr size_t O_MIX   = O_YS + (size_t)2 * T * 1024 * 2;
constexpr size_t O_HID   = O_MIX + (size_t)T * 1536 * 2;
constexpr size_t O_QR    = O_HID + (size_t)T * 2816 * 2;
constexpr size_t O_KR    = O_QR + (size_t)T * 1024 * 2;
constexpr size_t O_KRT   = O_KR + (size_t)T * 1024 * 2;
constexpr size_t O_VRT   = O_KRT + (size_t)T * 1024 * 2;
constexpr size_t O_GR    = O_VRT + (size_t)T * 2048 * 2;
constexpr size_t O_YR    = O_GR + (size_t)T * 2048 * 2;
constexpr size_t O_RG    = O_YR + (size_t)2 * T * 2048 * 2;
constexpr size_t O_GP    = O_RG + (size_t)T * 2048 * 2;
constexpr size_t WS_END  = O_GP + (size_t)192 * 4 * 16 * 256 * 4;

constexpr size_t OUT_Y = 0, OUT_K = (size_t)T * 1024, OUT_V = OUT_K + (size_t)TC * 512, OUT_SSD = OUT_V + (size_t)TC * 512,
                 OUT_RET = OUT_SSD + (size_t)32 * 2 * 16 * 128 * 64;

struct Params { const float* in[36]; float* out; unsigned char* ws; int ph_lo, ph_hi; };

typedef float f32x2 __attribute__((ext_vector_type(2)));
typedef __bf16 nbf16x2 __attribute__((ext_vector_type(2)));
__device__ __forceinline__ unsigned cvt_pk_bf16(float lo, float hi) { const f32x2 v = {lo, hi}; const nbf16x2 b = __builtin_convertvector(v, nbf16x2); return __builtin_bit_cast(unsigned, b); }
__device__ __forceinline__ bf16_t f2bf(float x) { return (bf16_t)(cvt_pk_bf16(x, 0.f) & 0xffffu); }
__device__ __forceinline__ float bf_lo(unsigned w) { return __uint_as_float(w << 16); }
__device__ __forceinline__ float bf_hi(unsigned w) { return __uint_as_float(w & 0xffff0000u); }
__device__ __forceinline__ float bf2f(bf16_t b) { return __uint_as_float((unsigned)b << 16); }
__device__ __forceinline__ void unpack8(u32x4 w, float (&x)[8]) { x[0] = bf_lo(w.x); x[1] = bf_hi(w.x); x[2] = bf_lo(w.y); x[3] = bf_hi(w.y); x[4] = bf_lo(w.z); x[5] = bf_hi(w.z); x[6] = bf_lo(w.w); x[7] = bf_hi(w.w); }
__device__ __forceinline__ float siluf(float x) { return x * __builtin_amdgcn_rcpf(1.f + __expf(-x)); }
__device__ __forceinline__ float softplusf(float x) { return x > 20.f ? x : log1pf(__expf(x)); }
__device__ __forceinline__ bf16x8 as_bf16x8(u32x4 v) { return __builtin_bit_cast(bf16x8, v); }
__device__ __forceinline__ f32x4 mfma16(bf16x8 a, bf16x8 b, f32x4 c) { return __builtin_amdgcn_mfma_f32_16x16x32_bf16(a, b, c, 0, 0, 0); }
__device__ __forceinline__ float wave_sum(float v) {
#pragma unroll
    for (int o = 32; o >= 1; o >>= 1) v += __shfl_xor(v, o);
    return v;
}

constexpr int BM = 256, BK = 64, HALF = 128, HTB = HALF * BK * 2;
__device__ __forceinline__ int lds_byte(int r, int c) { const int st = (r >> 4) * 2 + (c >> 5), rr = r & 15, cc = c & 31, ob = rr * 64 + cc * 2; return st * 1024 + (ob ^ (((ob >> 9) & 1) << 5)); }
__device__ __forceinline__ void stage_rc(int b, int& R, int& C) { const int st = b / 1024, sb = b % 1024, swz = sb ^ (((sb >> 9) & 1) << 5); R = (st >> 1) * 16 + swz / 64; C = (st & 1) * 32 + (swz % 64) / 2; }

__device__ __forceinline__ bool tile_of(int L, int nM, int nN, int& pm, int& pn) {
    const int nwg = nM * nN; if (L >= nwg) return false;
    int wgid = L; { const int q = nwg / 8, r = nwg % 8, xcd = wgid % 8, off = wgid / 8; wgid = (xcd < r ? xcd * (q + 1) : r * (q + 1) + (xcd - r) * q) + off; }
    const int nig = 8 * nN, gid = wgid / nig, fm = gid * 8, gsz = (nM - fm) < 8 ? (nM - fm) : 8;
    pm = fm + ((wgid % nig) % gsz); pn = (wgid % nig) / gsz; return true;
}

template <class Epi>
__device__ __forceinline__ void gemm_tile(LAS unsigned char* lds, const bf16_t* __restrict__ A, const bf16_t* __restrict__ Bt, const int K, const int brow, const int bcol, const Epi& epi) {
    const int tid = threadIdx.x, wid = __builtin_amdgcn_readfirstlane(tid >> 6), lane = tid & 63, wr = wid >> 2, wc = wid & 3, fr = lane & 15, fq = lane >> 4;
    unsigned voff[2], voffB[2];
#pragma unroll
    for (int i = 0; i < 2; ++i) { int R, C; stage_rc(tid * 16 + i * 8192, R, C); voff[i] = (unsigned)(R * K + C) * 2u;
        const int rho = R & 31, Rb = (R & ~31) + 8 * ((rho & 15) >> 2) + 4 * (rho >> 4) + (rho & 3); voffB[i] = (unsigned)(Rb * K + C) * 2u; }
    const unsigned ldsw = (unsigned)wid * 1024u;
    const int aoff = lds_byte(wr * 64 + fr, fq * 8), boff = lds_byte(wc * 32 + fr, fq * 8);
    const char* cA = (const char*)(A + (size_t)brow * K); const char* cB = (const char*)(Bt + (size_t)bcol * K);
    const size_t kstep = (size_t)BK * 2, hstep = (size_t)HALF * K * 2;
#define SA(b, h) (((b) * 2 + (h)) * HTB)
#define SB(b, h) ((4 + (b) * 2 + (h)) * HTB)
#define STAGE(bufoff, gbase) do { _Pragma("unroll") for (int _i = 0; _i < 2; ++_i) \
        __builtin_amdgcn_global_load_lds((const unsigned*)((gbase) + ((bufoff) >= 4 * HTB ? voffB[_i] : voff[_i])), (LAS unsigned*)(lds + (bufoff) + ldsw + _i * 8192), 16, 0, 0); } while (0)
#define LDA(dst, b, h) do { _Pragma("unroll") for (int m = 0; m < 4; ++m) _Pragma("unroll") for (int k = 0; k < 2; ++k) dst[m][k] = *(const LAS bf16x8*)(lds + SA(b, h) + aoff + m * 2048 + k * 1024); } while (0)
#define LDB(dst, b, h) do { _Pragma("unroll") for (int n = 0; n < 2; ++n) _Pragma("unroll") for (int k = 0; k < 2; ++k) dst[n][k] = *(const LAS bf16x8*)(lds + SB(b, h) + boff + n * 2048 + k * 1024); } while (0)
#define MMA(ai, bj, At, Bt_) do { __builtin_amdgcn_s_setprio(1); _Pragma("unroll") for (int m = 0; m < 4; ++m) _Pragma("unroll") for (int n = 0; n < 2; ++n) _Pragma("unroll") for (int k = 0; k < 2; ++k) \
        acc[ai][bj][m][n] = __builtin_amdgcn_mfma_f32_16x16x32_bf16(Bt_[n][k], At[m][k], acc[ai][bj][m][n], 0, 0, 0); __builtin_amdgcn_s_setprio(0); } while (0)
#define WAIT_V(n) asm volatile("s_waitcnt vmcnt(" #n ")" ::: "memory")
#define WAIT_L(n) asm volatile("s_waitcnt lgkmcnt(" #n ")" ::: "memory")
#define BAR __builtin_amdgcn_s_barrier()
#define SCHED __builtin_amdgcn_sched_barrier(0)
    f32x4 acc[2][2][4][2];
#pragma unroll
    for (int a = 0; a < 2; ++a)
#pragma unroll
        for (int b = 0; b < 2; ++b)
#pragma unroll
            for (int m = 0; m < 4; ++m)
#pragma unroll
                for (int n = 0; n < 2; ++n) acc[a][b][m][n] = (f32x4){0.f, 0.f, 0.f, 0.f};
    bf16x8 At[4][2], B0[2][2], B1[2][2];
    const int nt = K / BK;
    STAGE(SB(0, 0), cB); STAGE(SA(0, 0), cA); STAGE(SB(0, 1), cB + hstep); STAGE(SA(0, 1), cA + hstep);
    if (wr == 1) BAR;
    WAIT_V(4); BAR;
    STAGE(SB(1, 0), cB + kstep); STAGE(SA(1, 0), cA + kstep); STAGE(SB(1, 1), cB + hstep + kstep);
    WAIT_V(6); BAR;
    for (int t = 0; t < nt - 2; t += 2) {
        const char* a1 = cA + (size_t)(t + 1) * kstep; const char* a2 = cA + (size_t)(t + 2) * kstep; const char* b2 = cB + (size_t)(t + 2) * kstep;
        const char* a3 = a2 + kstep; const char* b3 = b2 + kstep;
        LDB(B0, 0, 0); SCHED; LDA(At, 0, 0); STAGE(SA(1, 1), a1 + hstep);
        WAIT_L(8); BAR; WAIT_L(0); MMA(0, 0, At, B0); BAR; SCHED;
        LDB(B1, 0, 1); STAGE(SB(0, 0), b2);
        BAR; WAIT_L(0); MMA(0, 1, At, B1); BAR;
        LDA(At, 0, 1); STAGE(SA(0, 0), a2);
        BAR; WAIT_L(0); MMA(1, 0, At, B0); BAR; SCHED;
        STAGE(SB(0, 1), b2 + hstep);
        WAIT_V(6); BAR; MMA(1, 1, At, B1); BAR;
        LDB(B0, 1, 0); SCHED; LDA(At, 1, 0); STAGE(SA(0, 1), a2 + hstep);
        WAIT_L(8); BAR; WAIT_L(0); MMA(0, 0, At, B0); BAR; SCHED;
        LDB(B1, 1, 1); STAGE(SB(1, 0), b3);
        BAR; WAIT_L(0); MMA(0, 1, At, B1); BAR;
        LDA(At, 1, 1); STAGE(SA(1, 0), a3);
        BAR; WAIT_L(0); MMA(1, 0, At, B0); BAR; SCHED;
        STAGE(SB(1, 1), b3 + hstep);
        WAIT_V(6); BAR; MMA(1, 1, At, B1); BAR;
    }
    { const char* a1 = cA + (size_t)(nt - 1) * kstep;
      LDB(B0, 0, 0); LDA(At, 0, 0); STAGE(SA(1, 1), a1 + hstep);
      BAR; WAIT_L(0); MMA(0, 0, At, B0); BAR;
      LDB(B1, 0, 1); BAR; WAIT_L(0); MMA(0, 1, At, B1); BAR;
      LDA(At, 0, 1); WAIT_V(4); BAR; WAIT_L(0); MMA(1, 0, At, B0); MMA(1, 1, At, B1); BAR; }
    { LDB(B0, 1, 0); LDA(At, 1, 0); WAIT_V(2); BAR; WAIT_L(0); MMA(0, 0, At, B0); BAR;
      LDB(B1, 1, 1); WAIT_V(0); BAR; WAIT_L(0); MMA(0, 1, At, B1); BAR;
      LDA(At, 1, 1); BAR; WAIT_L(0); MMA(1, 0, At, B0); MMA(1, 1, At, B1); BAR; }
    if (wr == 0) BAR;
    epi(acc, brow, bcol, wr, wc, fr, fq);
    WAIT_V(0);
    __syncthreads();
#undef SA
#undef SB
#undef STAGE
#undef LDA
#undef LDB
#undef MMA
#undef WAIT_V
#undef WAIT_L
#undef BAR
#undef SCHED
}

template <class F>
__device__ __forceinline__ void epi_each(const f32x4 (&acc)[2][2][4][2], int brow, int bcol, int wr, int wc, int fr, int fq, F f) {
#pragma unroll
    for (int ai = 0; ai < 2; ++ai)
#pragma unroll
        for (int m = 0; m < 4; ++m)
#pragma unroll
            for (int bj = 0; bj < 2; ++bj) f(brow + ai * 128 + wr * 64 + m * 16 + fr, bcol + bj * 128 + wc * 32 + fq * 8, acc[ai][bj][m][0], acc[ai][bj][m][1]);
}
__device__ __forceinline__ void st_bf16x4(bf16_t* p, f32x4 v) { u32x2 w; w.x = cvt_pk_bf16(v[0], v[1]); w.y = cvt_pk_bf16(v[2], v[3]); *(u32x2*)p = w; }
__device__ __forceinline__ void st_bf16x8(bf16_t* p, f32x4 a, f32x4 b) { u32x4 w; w.x = cvt_pk_bf16(a[0], a[1]); w.y = cvt_pk_bf16(a[2], a[3]); w.z = cvt_pk_bf16(b[0], b[1]); w.w = cvt_pk_bf16(b[2], b[3]); *(u32x4*)p = w; }
__device__ __forceinline__ void st_bf16_T(bf16_t* base, size_t col, int row, f32x4 v) {
#pragma unroll
    for (int j = 0; j < 4; ++j) base[(col + j) * (size_t)T + row] = f2bf(v[j]);
}

struct EpiIn0 {
    bf16_t *Q0, *K0, *V0T, *Z, *XBC; float *DT, *outK, *outV;
    __device__ __forceinline__ void operator()(const f32x4 (&acc)[2][2][4][2], int brow, int bcol, int wr, int wc, int fr, int fq) const {
        if (bcol < 512) epi_each(acc, brow, bcol, wr, wc, fr, fq, [&](int r, int c, f32x4 v, f32x4 w) { st_bf16x8(Q0 + (size_t)r * 512 + c, v * 0.125f, w * 0.125f); });
        else if (bcol < 1024) epi_each(acc, brow, bcol, wr, wc, fr, fq, [&](int r, int c, f32x4 v, f32x4 w) { c -= 512; st_bf16x8(K0 + (size_t)r * 512 + c, v, w);
            if (r < TC) { *(f32x4*)(outK + (size_t)r * 512 + c) = v; *(f32x4*)(outK + (size_t)r * 512 + c + 4) = w; } });
        else if (bcol < 1536) epi_each(acc, brow, bcol, wr, wc, fr, fq, [&](int r, int c, f32x4 v, f32x4 w) { c -= 1024; st_bf16_T(V0T, c, r, v); st_bf16_T(V0T, c + 4, r, w);
            if (r < TC) { *(f32x4*)(outV + (size_t)r * 512 + c) = v; *(f32x4*)(outV + (size_t)r * 512 + c + 4) = w; } });
        else if (bcol < 2560) epi_each(acc, brow, bcol, wr, wc, fr, fq, [&](int r, int c, f32x4 v, f32x4 w) { st_bf16x8(Z + (size_t)r * 1024 + (c - 1536), v, w); });
        else epi_each(acc, brow, bcol, wr, wc, fr, fq, [&](int r, int c, f32x4 v, f32x4 w) { st_bf16x8(XBC + (size_t)r * 1536 + (c - 2560), v, w); });
    }
};
struct EpiRes {
    const float *baseA, *baseB;
    float* XA; const float* gate;
    __device__ __forceinline__ void operator()(const f32x4 (&acc)[2][2][4][2], int brow, int bcol, int wr, int wc, int fr, int fq) const {
        const float* base = brow < TC ? baseA : baseB - (size_t)TC * 1024;
        const float* g = gate + (brow < TC ? 0 : (1 + (brow - TC) / 1024) * 6144);
        const int cb = bcol + wc * 32 + fq * 8;
        const f32x4 g00 = *(const f32x4*)(g + cb), g01 = *(const f32x4*)(g + cb + 4), g10 = *(const f32x4*)(g + cb + 128), g11 = *(const f32x4*)(g + cb + 132);
        epi_each(acc, brow, bcol, wr, wc, fr, fq, [&](int r, int c, f32x4 v, f32x4 w) {
            const f32x4 b0 = *(const f32x4*)(base + (size_t)r * 1024 + c), b1 = *(const f32x4*)(base + (size_t)r * 1024 + c + 4); const bool hi = (c - cb) != 0;
            *(f32x4*)(XA + (size_t)r * 1024 + c) = b0 + (hi ? g10 : g00) * v; *(f32x4*)(XA + (size_t)r * 1024 + c + 4) = b1 + (hi ? g11 : g01) * w; });
    }
};
struct EpiSwiglu {
    bf16_t* HID;
    __device__ __forceinline__ void operator()(const f32x4 (&acc)[2][2][4][2], int brow, int bcol, int wr, int wc, int fr, int fq) const {
        const int hc0 = (bcol >> 1) + wc * 32 + fq * 8;
#pragma unroll
        for (int ai = 0; ai < 2; ++ai)
#pragma unroll
            for (int m = 0; m < 4; ++m) {
                f32x4 o[2];
#pragma unroll
                for (int n = 0; n < 2; ++n) { const f32x4 a = acc[ai][0][m][n], b = acc[ai][1][m][n];
#pragma unroll
                    for (int j = 0; j < 4; ++j) o[n][j] = siluf(a[j]) * b[j]; }
                st_bf16x8(HID + (size_t)(brow + ai * 128 + wr * 64 + m * 16 + fr) * FFN + hc0, o[0], o[1]);
            }
    }
};
__device__ __forceinline__ f32x4 rope4(f32x4 v, int r, int c) {
    const int t = (r - TC) & 1023, grow = t >> 6, gcol = t & 63, d = c & 255, p0 = d >> 1;
    f32x4 o;
#pragma unroll
    for (int q = 0; q < 2; ++q) {
        const int p = p0 + q; const float pos = (float)(p < 64 ? grow : gcol);
        const float fr_ = exp2f(-(float)(p & 63) * (13.287712379549449f / 64.f));
        const float ang = pos * fr_; const float cs = __cosf(ang), sn = __sinf(ang);
        const float x1 = v[2 * q], x2 = v[2 * q + 1];
        o[2 * q] = x1 * cs - x2 * sn; o[2 * q + 1] = x1 * sn + x2 * cs;
    }
    return o;
}
struct EpiIn1 {
    bf16_t *QR, *KR, *KRT, *VRT, *GR;
    __device__ __forceinline__ void operator()(const f32x4 (&acc)[2][2][4][2], int brow, int bcol, int wr, int wc, int fr, int fq) const {
        const bool lat = brow >= TC;
        if (bcol < 1024) epi_each(acc, brow, bcol, wr, wc, fr, fq, [&](int r, int c, f32x4 v, f32x4 w) { if (lat) { v = rope4(v, r, c); w = rope4(w, r, c + 4); } st_bf16x8(QR + (size_t)r * 1024 + c, v, w); });
        else if (bcol < 2048) epi_each(acc, brow, bcol, wr, wc, fr, fq, [&](int r, int c, f32x4 v, f32x4 w) { c -= 1024; v = v * 0.0625f; w = w * 0.0625f; if (lat) { v = rope4(v, r, c); w = rope4(w, r, c + 4); }
            st_bf16x8(KR + (size_t)r * 1024 + c, v, w); st_bf16_T(KRT, c, r, v); st_bf16_T(KRT, c + 4, r, w); });
        else if (bcol < 4096) epi_each(acc, brow, bcol, wr, wc, fr, fq, [&](int r, int c, f32x4 v, f32x4 w) { st_bf16_T(VRT, c - 2048, r, v); st_bf16_T(VRT, c - 2048 + 4, r, w); });
        else epi_each(acc, brow, bcol, wr, wc, fr, fq, [&](int r, int c, f32x4 v, f32x4 w) { st_bf16x8(GR + (size_t)r * 2048 + (c - 4096), v, w); });
    }
};

__device__ __forceinline__ void prep_phase(const Params& p, LAS unsigned char* lds, const int part, const int bx, const int G);
template <class Epi>
__device__ __forceinline__ void gemm_phase(LAS unsigned char* lds, const bf16_t* A, const bf16_t* Bt, int N, int K, const Epi& epi, const Params* pp = nullptr, int idle_part = 0) {
    const int nM = T / BM, nN = N / BM;
    if (idle_part && (int)blockIdx.x >= nM * nN) { prep_phase(*pp, lds, idle_part, (int)blockIdx.x - nM * nN, (int)gridDim.x - nM * nN); return; }
    for (int i = 0;; ++i) { int pm, pn; if (!tile_of(i * (int)gridDim.x + (int)blockIdx.x, nM, nN, pm, pn)) break; gemm_tile(lds, A, Bt, K, pm * BM, pn * BM, epi); }
}

__device__ __forceinline__ void transpose_tile(LAS unsigned char* lds, const float* __restrict__ src, int N, int k0, int n0, bf16_t* __restrict__ dst, int drow0, int ldd) {
    LAS float* tl = (LAS float*)lds; const int tid = threadIdx.x;
#pragma unroll
    for (int i = 0; i < 2; ++i) { const int r = (tid >> 4) + 32 * i, c = (tid & 15) * 4;
        f32x4 v = (f32x4){0.f, 0.f, 0.f, 0.f}; if (n0 + c < N) v = *(const f32x4*)(src + (size_t)(k0 + r) * N + n0 + c);
        tl[r * 65 + c] = v[0]; tl[r * 65 + c + 1] = v[1]; tl[r * 65 + c + 2] = v[2]; tl[r * 65 + c + 3] = v[3]; }
    __syncthreads();
    { const int n = tid >> 3, kg = (tid & 7) * 8; float x[8];
#pragma unroll
      for (int e = 0; e < 8; ++e) x[e] = tl[(kg + e) * 65 + n];
      u32x4 w; w.x = cvt_pk_bf16(x[0], x[1]); w.y = cvt_pk_bf16(x[2], x[3]); w.z = cvt_pk_bf16(x[4], x[5]); w.w = cvt_pk_bf16(x[6], x[7]);
      *(u32x4*)(dst + (size_t)(drow0 + n) * ldd + k0 + kg) = w; }
    __syncthreads();
}
struct TJob { const float* src; bf16_t* dst; int K, N, Npad, mode; };
__device__ __forceinline__ void prep_phase(const Params& p, LAS unsigned char* lds, const int part, const int bx, const int G) {
    unsigned char* ws = p.ws; const int tid = threadIdx.x;
    const int mod_lo = part == 0 ? 0 : 96, mod_hi = part == 0 ? 96 : (part == 1 ? 192 : 96), job_lo = part == 0 ? 0 : 5, job_hi = part == 0 ? 5 : (part == 2 ? 10 : 5);
    float* MOD = (float*)(ws + O_MOD);
    if (mod_lo + bx < mod_hi) {
        LAS float* sc = (LAS float*)lds;
        LAS float* part = sc + 5 * 1024;
        for (int u = tid; u < 5 * 1024; u += NTHR) { const int ci = u >> 10, k = u & 1023; const float c = ci == 0 ? p.in[7][k] : p.in[6][(ci - 1) * 1024 + k]; sc[u] = siluf(c); }
        __syncthreads();
        for (int it = mod_lo + bx; it < mod_hi; it += G) {
            const int l = it / 96, n0 = (it % 96) * 64; const float* W = p.in[l == 0 ? 10 : 26]; const float* Bv = p.in[l == 0 ? 11 : 27];
            const int w = tid >> 6, lane = tid & 63; float a[5] = {0.f, 0.f, 0.f, 0.f, 0.f};
            for (int k = w * 128; k < w * 128 + 128; ++k) { const float wv = W[(size_t)k * 6144 + n0 + lane];
#pragma unroll
                for (int ci = 0; ci < 5; ++ci) a[ci] += sc[ci * 1024 + k] * wv; }
#pragma unroll
            for (int ci = 0; ci < 5; ++ci) part[(w * 5 + ci) * 64 + lane] = a[ci];
            __syncthreads();
            if (tid < 320) { const int ci = tid >> 6, ln = tid & 63; float s = 0.f;
#pragma unroll
                for (int w2 = 0; w2 < 8; ++w2) s += part[(w2 * 5 + ci) * 64 + ln];
                MOD[(size_t)(l * 5 + ci) * 6144 + n0 + ln] = s + Bv[n0 + ln]; }
            __syncthreads();
        }
    }
    if (part == 0) { bf16_t* CK = (bf16_t*)(ws + O_CK); const float* src = p.in[2];
      for (int u = bx * NTHR + tid; u < 4 * 256 * 512 / 4; u += G * NTHR) { const f32x4 v = *(const f32x4*)(src + (size_t)u * 4); st_bf16x4(CK + (size_t)u * 4, v); } }
    for (int j = job_lo; j < (part == 0 ? 14 : job_hi); ++j) {
        if (part == 0 && j >= 5 && j < 10) continue;
        TJob jb;
        switch (j) {
            case 0: jb = {p.in[12], (bf16_t*)(ws + O_W0IN), 1024, 4128, 4352, 0}; break;
            case 1: jb = {p.in[13], (bf16_t*)(ws + O_W0OUT), 1536, 1024, 1024, 0}; break;
            case 2: jb = {p.in[21], (bf16_t*)(ws + O_W0UP), 1024, 2816, 2816, 1}; break;
            case 3: jb = {p.in[22], (bf16_t*)(ws + O_W0UP), 1024, 2816, 2816, 2}; break;
            case 4: jb = {p.in[23], (bf16_t*)(ws + O_W0DN), 2816, 1024, 1024, 0}; break;
            case 5: jb = {p.in[28], (bf16_t*)(ws + O_W1IN), 1024, 6144, 6144, 0}; break;
            case 6: jb = {p.in[29], (bf16_t*)(ws + O_W1OUT), 2048, 1024, 1024, 0}; break;
            case 7: jb = {p.in[32], (bf16_t*)(ws + O_W1UP), 1024, 2816, 2816, 1}; break;
            case 8: jb = {p.in[33], (bf16_t*)(ws + O_W1UP), 1024, 2816, 2816, 2}; break;
            case 9: jb = {p.in[34], (bf16_t*)(ws + O_W1DN), 2816, 1024, 1024, 0}; break;
            default: jb = {p.in[3] + (size_t)(j - 10) * 256 * 512, (bf16_t*)(ws + O_CVT) + (size_t)(j - 10) * 512 * 256, 256, 512, 512, 0}; break;
        }
        const int nkt = jb.K / 64, nnt = jb.Npad / 64, ntile = nkt * nnt;
        for (int tix = (bx + 64 * j) % G; tix < ntile; tix += G) {
            const int kt = tix % nkt, ntl = tix / nkt, n0 = ntl * 64;
            int drow0 = n0; if (jb.mode) drow0 = (n0 / 128) * 256 + (n0 % 128) + (jb.mode == 2 ? 128 : 0);
            transpose_tile(lds, jb.src, jb.N, kt * 64, n0, jb.dst, drow0, jb.K);
        }
    }
}

__device__ __forceinline__ void norm_phase(const float* xa, const float* xb, const float* nw, const float* mod  , int sh_off, int sc_off, bf16_t* H, float* outf) {
    const int lane = threadIdx.x & 63, gw = blockIdx.x * 8 + (threadIdx.x >> 6), nw_tot = gridDim.x * 8;
    for (int r0 = gw; r0 < T; r0 += 2 * nw_tot) {
        const int r1 = r0 + nw_tot < T ? r0 + nw_tot : r0;
        f32x4 v[2][4]; float ss[2];
#pragma unroll
        for (int u = 0; u < 2; ++u) { const int r = u ? r1 : r0; const float* x = r < TC ? xa + (size_t)r * 1024 : xb + (size_t)(r - TC) * 1024; ss[u] = 0.f;
#pragma unroll
            for (int q = 0; q < 4; ++q) { v[u][q] = *(const f32x4*)(x + (q >> 1) * 512 + lane * 8 + (q & 1) * 4); ss[u] += v[u][q][0] * v[u][q][0] + v[u][q][1] * v[u][q][1] + v[u][q][2] * v[u][q][2] + v[u][q][3] * v[u][q][3]; } }
#pragma unroll
        for (int u = 0; u < 2; ++u) {
            const int r = u ? r1 : r0; if (u && r1 == r0) break;
            const float rstd = rsqrtf(wave_sum(ss[u]) * (1.f / 1024.f) + 1e-6f);
            if (outf) {
#pragma unroll
                for (int q = 0; q < 4; ++q) { const int c = (q >> 1) * 512 + lane * 8 + (q & 1) * 4; const f32x4 w = *(const f32x4*)(nw + c); *(f32x4*)(outf + (size_t)r * 1024 + c) = v[u][q] * rstd * w; }
            } else {
                const float* md = mod + (r < TC ? 0 : (1 + (r - TC) / 1024) * 6144);
#pragma unroll
                for (int h2 = 0; h2 < 2; ++h2) { const int c = h2 * 512 + lane * 8; f32x4 o[2];
#pragma unroll
                    for (int e = 0; e < 2; ++e) { const f32x4 w = *(const f32x4*)(nw + c + 4 * e), sc = *(const f32x4*)(md + sc_off + c + 4 * e), sh = *(const f32x4*)(md + sh_off + c + 4 * e);
                        o[e] = v[u][h2 * 2 + e] * rstd * w * (sc + 1.f) + sh; }
                    st_bf16x8(H + (size_t)r * 1024 + c, o[0], o[1]); }
            }
        }
    }
}

__device__ __forceinline__ void conv_phase(const Params& p, LAS unsigned char* lds) {
    unsigned char* ws = p.ws; const bf16_t* XBC = (const bf16_t*)(ws + O_XBC); bf16_t* XC = (bf16_t*)(ws + O_XC); bf16_t* XT = (bf16_t*)(ws + O_XT);
    const float* cw = p.in[15]; const float* cb = p.in[16];
    const int tid = threadIdx.x; LAS bf16_t* tl = (LAS bf16_t*)lds;
    for (int it = blockIdx.x; it < 96 * 24; it += gridDim.x) {
        const int tt = it / 24, ct = it % 24, tok0 = tt * 128, c0 = ct * 64;
        const int L = tok0 < TC ? 256 : 1024, ts0 = tok0 < TC ? (tok0 & 255) : ((tok0 - TC) & 1023);
        const int tp = (tid >> 3) * 2, cg_ = (tid & 7) * 8, tok = tok0 + tp, ts = ts0 + tp, ch = c0 + cg_;
        u32x4 rw[6];
#pragma unroll
        for (int k = 0; k < 6; ++k) { const int tsk = ts + k - 2; rw[k] = (u32x4){0u, 0u, 0u, 0u}; if (tsk >= 0 && tsk < L) rw[k] = *(const u32x4*)(XBC + (size_t)(tok + k - 2) * 1536 + ch); }
        float a0[8], a1[8];
        { const f32x4 b0 = *(const f32x4*)(cb + ch), b1 = *(const f32x4*)(cb + ch + 4);
#pragma unroll
          for (int e = 0; e < 4; ++e) { a0[e] = b0[e]; a0[e + 4] = b1[e]; a1[e] = b0[e]; a1[e + 4] = b1[e]; } }
#pragma unroll
        for (int k = 0; k < 5; ++k) { const f32x4 w0 = *(const f32x4*)(cw + k * 1536 + ch), w1 = *(const f32x4*)(cw + k * 1536 + ch + 4);
            float x0[8], x1[8]; unpack8(rw[k], x0); unpack8(rw[k + 1], x1);
#pragma unroll
            for (int e = 0; e < 8; ++e) { const float wv = e < 4 ? w0[e] : w1[e - 4]; a0[e] += wv * x0[e]; a1[e] += wv * x1[e]; } }
#pragma unroll
        for (int e = 0; e < 8; ++e) { a0[e] = siluf(a0[e]); a1[e] = siluf(a1[e]); }
        u32x4 o0, o1; o0.x = cvt_pk_bf16(a0[0], a0[1]); o0.y = cvt_pk_bf16(a0[2], a0[3]); o0.z = cvt_pk_bf16(a0[4], a0[5]); o0.w = cvt_pk_bf16(a0[6], a0[7]);
        o1.x = cvt_pk_bf16(a1[0], a1[1]); o1.y = cvt_pk_bf16(a1[2], a1[3]); o1.z = cvt_pk_bf16(a1[4], a1[5]); o1.w = cvt_pk_bf16(a1[6], a1[7]);
        *(u32x4*)(XC + (size_t)tok * 1536 + ch) = o0; *(u32x4*)(XC + (size_t)(tok + 1) * 1536 + ch) = o1;
        if (ct < 20) {
#pragma unroll
            for (int e = 0; e < 8; ++e) *(LAS unsigned*)(tl + (cg_ + e) * 136 + tp) = cvt_pk_bf16(a0[e], a1[e]);
            __syncthreads();
#pragma unroll
            for (int q = 0; q < 2; ++q) { const int pid = q * NTHR + tid, chl = pid >> 4, tg = (pid & 15) * 8;
                const u32x4 w = *(const LAS u32x4*)(tl + chl * 136 + tg);
                *(u32x4*)(XT + (size_t)(c0 + chl) * T + tok0 + tg) = w; }
            __syncthreads();
        }
    }
}

struct NaState { float m, l; f32x4 o[4]; };
struct NaChunk { const bf16_t* kb; const bf16_t* vtb; size_t ldv; const LAS float* biasrow; int kc0; bool local; int tile;   };
__device__ __forceinline__ void na_load(const NaChunk& ch, int fr, int fq, bf16x8 (&kf)[2][2], u32x4 (&vw)[4]) {
#pragma unroll
    for (int t = 0; t < 2; ++t)
#pragma unroll
        for (int ks = 0; ks < 2; ++ks) kf[t][ks] = *(const bf16x8*)(ch.kb + (size_t)(16 * t + fr) * 512 + ks * 32 + fq * 8);
#pragma unroll
    for (int dt = 0; dt < 4; ++dt) { const bf16_t* vp = ch.vtb + (size_t)(dt * 16 + fr) * ch.ldv + 4 * fq;
        const u32x2 lo = *(const u32x2*)vp, hi = *(const u32x2*)(vp + 16); vw[dt].x = lo.x; vw[dt].y = lo.y; vw[dt].z = hi.x; vw[dt].w = hi.y; }
}
__device__ __forceinline__ void na_compute(NaState& st, const bf16x8 (&qf)[2], const bf16x8 (&kf)[2][2], const u32x4 (&vw)[4], const NaChunk& ch, int fq, int qc) {
    f32x4 s[2];
#pragma unroll
    for (int t = 0; t < 2; ++t) { s[t] = (f32x4){0.f, 0.f, 0.f, 0.f};
#pragma unroll
        for (int ks = 0; ks < 2; ++ks) s[t] = mfma16(kf[t][ks], qf[ks], s[t]); }
    if (ch.local) {
        const int c0 = min(max(qc - 8, 0), 48);
#pragma unroll
        for (int t = 0; t < 2; ++t)
#pragma unroll
            for (int j = 0; j < 4; ++j) { const int kc = ch.kc0 + 16 * t + 4 * fq + j; const bool ok = kc >= c0 && kc < c0 + 16; const int dc = min(max(kc - qc + 15, 0), 30);
                s[t][j] = ok ? s[t][j] + ch.biasrow[dc] : -INFINITY; }
    }
    float mx = fmaxf(fmaxf(fmaxf(s[0][0], s[0][1]), fmaxf(s[0][2], s[0][3])), fmaxf(fmaxf(s[1][0], s[1][1]), fmaxf(s[1][2], s[1][3])));
    mx = fmaxf(mx, __shfl_xor(mx, 16)); mx = fmaxf(mx, __shfl_xor(mx, 32));
    const float mn = fmaxf(st.m, mx), alpha = __expf(st.m - mn); st.m = mn;
    float ps = 0.f;
#pragma unroll
    for (int t = 0; t < 2; ++t)
#pragma unroll
        for (int j = 0; j < 4; ++j) { s[t][j] = __expf(s[t][j] - mn); ps += s[t][j]; }
    st.l = st.l * alpha + ps;
    u32x4 pw; pw.x = cvt_pk_bf16(s[0][0], s[0][1]); pw.y = cvt_pk_bf16(s[0][2], s[0][3]); pw.z = cvt_pk_bf16(s[1][0], s[1][1]); pw.w = cvt_pk_bf16(s[1][2], s[1][3]);
    const bf16x8 pf = as_bf16x8(pw);
#pragma unroll
    for (int dt = 0; dt < 4; ++dt) st.o[dt] = mfma16(as_bf16x8(vw[dt]), pf, st.o[dt] * alpha);
}
__device__ __forceinline__ void na_phase(const Params& p, LAS unsigned char* lds) {
    unsigned char* ws = p.ws; const bf16_t* Q0 = (const bf16_t*)(ws + O_Q0); const bf16_t* K0 = (const bf16_t*)(ws + O_K0); const bf16_t* V0T = (const bf16_t*)(ws + O_V0T);
    const bf16_t* CK = (const bf16_t*)(ws + O_CK); const bf16_t* CVT = (const bf16_t*)(ws + O_CVT); bf16_t* MIX = (bf16_t*)(ws + O_MIX); const float* nb = p.in[14];
    const int lane = threadIdx.x & 63, fr = lane & 15, fq = lane >> 4, gw = blockIdx.x * 8 + (threadIdx.x >> 6), nwv = gridDim.x * 8;
    LAS float* lnb = (LAS float*)(lds + 20480);
    for (int u = threadIdx.x; u < 8 * 465; u += NTHR) lnb[u] = nb[u];
    __syncthreads();
    { const bf16_t* H = (const bf16_t*)(ws + O_H); const bf16_t* W = (const bf16_t*)(ws + O_W0IN) + (size_t)4096 * 1024; float* DT = (float*)(ws + O_DT);
      for (int it = gw - 1024; it >= 0 && it < T / 16; it += nwv) {
          f32x4 d0 = (f32x4){0.f, 0.f, 0.f, 0.f}, d1 = d0;
#pragma unroll 8
          for (int ks = 0; ks < 32; ++ks) { const bf16x8 hf = *(const bf16x8*)(H + (size_t)(it * 16 + fr) * 1024 + ks * 32 + fq * 8);
              const bf16x8 w0 = *(const bf16x8*)(W + (size_t)fr * 1024 + ks * 32 + fq * 8), w1 = *(const bf16x8*)(W + (size_t)(16 + fr) * 1024 + ks * 32 + fq * 8);
              d0 = mfma16(w0, hf, d0); d1 = mfma16(w1, hf, d1); }
          *(f32x4*)(DT + (size_t)(it * 16 + fr) * 32 + 4 * fq) = d0; *(f32x4*)(DT + (size_t)(it * 16 + fr) * 32 + 16 + 4 * fq) = d1; } }
    const int bx = blockIdx.x, wv = threadIdx.x >> 6;
    for (int k = 0; k < 2; ++k) {
        int it;
        if (gridDim.x != 256) { it = gw * 2 + k; if (gw * 2 + k >= 3072) break; if (gw >= 512 && k == 0) { } it = (gw < 1024) ? (k ? -1 : gw) : 1024 + 2 * (gw - 1024) + k; if (it < 0) break; }
        else if (bx < 128) { if (k) break; const int q = (bx >> 3) * 8 + wv; it = ((q >> 5) << 8) | ((bx & 7) << 5) | (q & 31); }
        else { const int j = bx - 128, x = j & 7, idx = (j >> 3) * 16 + wv * 2 + k; it = 1024 + (((4 * x + (idx >> 6)) << 6) | (idx & 63)); }
        if (it >= 1024 + 2048) break;
        NaState st[2];
#pragma unroll
        for (int u = 0; u < 2; ++u) { st[u].m = -INFINITY; st[u].l = 0.f;
#pragma unroll
            for (int d = 0; d < 4; ++d) st[u].o[d] = (f32x4){0.f, 0.f, 0.f, 0.f}; }
        bf16x8 qf[2][2]; int qtok0, h, b, r = 0, qc0 = 0, NC = 8; const bool lat = it < 1024;
        if (lat) { b = it >> 8; h = (it >> 5) & 7; r = (it >> 1) & 15; qc0 = (it & 1) * 32; qtok0 = TC + b * 1024 + r * 64 + qc0 + fr; NC = 24; }
        else { const int u = it - 1024; b = u >> 6; h = (u >> 3) & 7; qtok0 = b * 256 + (u & 7) * 32 + fr; }
        const int r0 = min(max(r - 4, 0), 8);
#pragma unroll
        for (int u = 0; u < 2; ++u)
#pragma unroll
            for (int ks = 0; ks < 2; ++ks) qf[u][ks] = *(const bf16x8*)(Q0 + (size_t)(qtok0 + 16 * u) * 512 + h * 64 + ks * 32 + fq * 8);
        auto get = [&](int c) { NaChunk ch; ch.biasrow = lnb; ch.kc0 = 0; ch.local = false; ch.tile = -1;
            if (!lat) { const int ktok = b * 256 + c * 32; ch.kb = K0 + (size_t)ktok * 512 + h * 64; ch.vtb = V0T + (size_t)(h * 64) * T + ktok; ch.ldv = T; }
            else if (c < 8) { ch.kb = CK + (size_t)(b * 256 + c * 32) * 512 + h * 64; ch.vtb = CVT + (size_t)(b * 512 + h * 64) * 256 + c * 32; ch.ldv = 256; }
            else {
                const int l = c - 8, s_ = l >> 1, u = l & 1, br = r0 + s_, ct = qc0 + 16 * u, kc0 = min(min(max(ct - 8, 0), 48), 32), ktok = TC + b * 1024 + br * 64 + kc0;
                ch.kb = K0 + (size_t)ktok * 512 + h * 64; ch.vtb = V0T + (size_t)(h * 64) * T + ktok; ch.ldv = T; ch.biasrow = lnb + h * 465 + (br - r + 7) * 31; ch.kc0 = kc0; ch.local = true; ch.tile = u; }
            return ch; };
        bf16x8 kfa[2][2], kfb[2][2], kfc[2][2]; u32x4 vwa[4], vwb[4], vwc[4];
        { const NaChunk c0_ = get(0), c1_ = get(1); na_load(c0_, fr, fq, kfa, vwa); na_load(c1_, fr, fq, kfb, vwb); }
        auto step = [&](const bf16x8 (&kfx)[2][2], const u32x4 (&vwx)[4], bf16x8 (&kfy)[2][2], u32x4 (&vwy)[4], int c) {
            if (c + 2 < NC) { const NaChunk n2 = get(c + 2); na_load(n2, fr, fq, kfy, vwy); }
            const NaChunk cur = get(c);
            if (cur.tile != 1) na_compute(st[0], qf[0], kfx, vwx, cur, fq, qc0 + fr);
            if (cur.tile != 0) na_compute(st[1], qf[1], kfx, vwx, cur, fq, qc0 + 16 + fr);
        };
        for (int c = 0; c < NC; c += 3) {
            step(kfa, vwa, kfc, vwc, c);
            if (c + 1 < NC) step(kfb, vwb, kfa, vwa, c + 1);
            if (c + 2 < NC) step(kfc, vwc, kfb, vwb, c + 2);
        }
#pragma unroll
        for (int u = 0; u < 2; ++u) { float l = st[u].l; l += __shfl_xor(l, 16); l += __shfl_xor(l, 32); const float inv = 1.f / l;
#pragma unroll
            for (int dt = 0; dt < 4; ++dt) st_bf16x4(MIX + (size_t)(qtok0 + 16 * u) * 1536 + h * 64 + dt * 16 + 4 * fq, st[u].o[dt] * inv); }
    }
}

__device__ __forceinline__ LAS unsigned char* opq(LAS unsigned char* p) { asm volatile("" : "+v"(p)); return p; }
template <int DK, bool SSD, int DV, bool GPRE>
__device__ __forceinline__ void scan_item(LAS unsigned char* lds, const bf16_t* Qg, const bf16_t* Kg, int ldqk, const bf16_t* KTg, const bf16_t* VTg, int tok0, int nch, int dir,
                          const float* s0, float* sfin, int ldS, bf16_t* Y, int ldy, const float* DTp, float dtb, float aneg, const float* GPh  ) {
    constexpr int NKS = DK / 32, RS = DK * 2 + 16, TS = 144, NPT = DV / 16, NPW = NPT / 2  , NPI = NPT / 4  ;
    constexpr int OQ = 1024, OK_ = OQ + 64 * RS, OKT = GPRE ? OK_ : OK_ + 64 * RS, OVT = OKT + DK * TS, OS = OVT + DV * TS;
    static_assert(OS + DV * RS <= LDS_XB_OFF, "scan LDS budget");
    constexpr int NPQ = 64 * DK / 8 / NTHR, NPKT = DK * 8 / NTHR, NPV = DV * 8 / NTHR, C8 = DK / 8, NPK = GPRE ? 0 : NPQ;
    constexpr int TAB_OFF = SSD ? OS + DV * RS : 0, TAB_F = 208;
    static_assert(!SSD || TAB_OFF + 16 * TAB_F * 4 <= LDS_XB_OFF, "scan table budget");
    const int tid = threadIdx.x, wid = __builtin_amdgcn_readfirstlane(tid >> 6), lane = tid & 63, fr = lane & 15, fq = lane >> 4;
    const int it = wid & 3, ph = wid >> 2, i = it * 16 + fr;
    constexpr int RPQ = NTHR / C8;
    LAS unsigned char* const qb = opq(lds + OQ + i * RS + fq * 16);
    LAS unsigned char* const kb_ = opq(lds + OK_ + fr * RS + fq * 16);
    LAS unsigned char* const zb = opq(lds + OS + (NPW * ph * 16 + fr) * RS + fq * 16);
    LAS unsigned char* const ktb = opq(lds + OKT + (ph * NKS * 16 + fr) * TS + fq * 16);
    LAS unsigned char* const vyb = opq(lds + OVT + (NPW * ph * 16 + fr) * TS + fq * 8);
    LAS unsigned char* const vsb = opq(lds + OVT + (it * 16 + fr) * TS + fq * 16);
    LAS unsigned char* const stb = opq(lds + OS + (it * 16 + 4 * fq) * RS + (ph * NKS * 16 + fr) * 2);
    LAS unsigned char* const cqb = opq(lds + OQ + (tid / C8) * RS + (tid % C8) * 16);
    LAS unsigned char* const ckb = opq(lds + OK_ + (tid / C8) * RS + (tid % C8) * 16);
    LAS unsigned char* const cktb = opq(lds + OKT + (tid >> 3) * TS + (tid & 7) * 16);
    LAS unsigned char* const cvb = opq(lds + OVT + (tid >> 3) * TS + (tid & 7) * 16);
    u32x4 pf[NPQ + NPK + NPKT + NPV]; f32x4 gcur[4];
    auto issue = [&](int tokc) {
        int t_ = tid; asm volatile("" : "+v"(t_));
#pragma unroll
        for (int q = 0; q < NPQ; ++q) { const int pid = q * NTHR + t_, row = pid / C8, c8 = pid % C8;
            pf[q] = *(const u32x4*)(Qg + (size_t)(tokc + row) * ldqk + c8 * 8); if (!GPRE) pf[NPQ + q] = *(const u32x4*)(Kg + (size_t)(tokc + row) * ldqk + c8 * 8); }
#pragma unroll
        for (int q = 0; q < NPKT; ++q) { const int pid = q * NTHR + t_, n = pid >> 3, tg = pid & 7; pf[NPQ + NPK + q] = *(const u32x4*)(KTg + (size_t)n * T + tokc + tg * 8); }
#pragma unroll
        for (int q = 0; q < NPV; ++q) { const int pid = q * NTHR + t_, pr = pid >> 3, tg = pid & 7; pf[NPQ + NPK + NPKT + q] = *(const u32x4*)(VTg + (size_t)pr * T + tokc + tg * 8); }
    };
    auto issue_g = [&](int tokc) {
#pragma unroll
        for (int jt = 0; jt < 4; ++jt) if (dir ? (jt >= it) : (jt <= it)) gcur[jt] = *(const f32x4*)(GPh + ((size_t)((tokc >> 6) * 4 * 16 + it * 4 + jt) * 64 + lane) * 4);
    };
    auto commit = [&]() {
#pragma unroll
        for (int q = 0; q < NPQ; ++q) { *(LAS u32x4*)(cqb + q * RPQ * RS) = pf[q]; if (!GPRE) *(LAS u32x4*)(ckb + q * RPQ * RS) = pf[NPQ + q]; }
#pragma unroll
        for (int q = 0; q < NPKT; ++q) *(LAS u32x4*)(cktb + q * 64 * TS) = pf[NPQ + NPK + q];
#pragma unroll
        for (int q = 0; q < NPV; ++q) *(LAS u32x4*)(cvb + q * 64 * TS) = pf[NPQ + NPK + NPKT + q];
    };
    const bool oddl = fr & 1;
    LAS unsigned char* const stb2 = opq(stb + (oddl ? 2 * RS - 2 : 0));
    auto put_state = [&](const f32x4 (&sacc)[NPI][NKS]) {
#pragma unroll
        for (int pi = 0; pi < NPI; ++pi)
#pragma unroll
            for (int q = 0; q < NKS; ++q) { const f32x4 a = sacc[pi][q];
                const float s0_ = oddl ? a[0] : a[2], s1_ = oddl ? a[1] : a[3];
                const float r0_ = __int_as_float(__builtin_amdgcn_update_dpp(0, __float_as_int(s0_), 0xB1, 0xF, 0xF, true));
                const float r1_ = __int_as_float(__builtin_amdgcn_update_dpp(0, __float_as_int(s1_), 0xB1, 0xF, 0xF, true));
                const unsigned w0 = oddl ? cvt_pk_bf16(r0_, a[2]) : cvt_pk_bf16(a[0], r0_), w1 = oddl ? cvt_pk_bf16(r1_, a[3]) : cvt_pk_bf16(a[1], r1_);
                *(LAS unsigned*)(stb2 + (pi * 64) * RS + q * 32) = w0; *(LAS unsigned*)(stb2 + (pi * 64 + 1) * RS + q * 32) = w1; }
    };
    issue(tok0 + (dir ? nch - 1 : 0) * 64);
    for (int c = wid; c < (SSD ? nch : 1); c += 8) {
        float dt = 1.f, a = aneg;
        if (SSD) { dt = softplusf(DTp[(size_t)(tok0 + c * 64 + lane) * 32] + dtb); a = dt * aneg; }
        float cs = a;
#pragma unroll
        for (int o = 1; o < 64; o <<= 1) { const float v = __shfl_up(cs, o); if (lane >= o) cs += v; }
        const float tot = __shfl(cs, 63), e = dir ? (tot - cs + a) : cs;
        LAS float* tb = (LAS float*)(lds + TAB_OFF) + c * TAB_F;
        tb[lane] = e; tb[64 + lane] = dt; tb[128 + lane] = dt * __expf(tot - e); if (lane == 0) tb[192] = tot;
    }
    f32x4 sacc[NPI][NKS];
#pragma unroll
    for (int pi = 0; pi < NPI; ++pi)
#pragma unroll
        for (int q = 0; q < NKS; ++q) { const int nt = ph * NKS + q, ptl = it + 4 * pi;
            sacc[pi][q] = s0 ? *(const f32x4*)(s0 + (size_t)(nt * 16 + fr) * ldS + ptl * 16 + 4 * fq) : (f32x4){0.f, 0.f, 0.f, 0.f}; }
    put_state(sacc);
#pragma unroll
    for (int jt = 0; jt < 4; ++jt) gcur[jt] = (f32x4){0.f, 0.f, 0.f, 0.f};
    if (GPRE) issue_g(tok0 + (dir ? nch - 1 : 0) * 64);
    commit();
    for (int cc = 0; cc < nch; ++cc) {
        const int c = dir ? nch - 1 - cc : cc, tokc = tok0 + c * 64;
        const bool has_next = cc + 1 < nch; const int tokn = tok0 + (dir ? c - 1 : c + 1) * 64;
        if (!GPRE && has_next) issue(tokn);
        LAS float* const le = (LAS float*)(lds + TAB_OFF) + (SSD ? c : 0) * TAB_F; LAS float* const ldtv = le + 64; LAS float* const ldtt = le + 128; LAS float* const lE = le + 192;
        __syncthreads();
        const float ei = le[i];
        bf16x8 qf[NKS];
        if (!GPRE) {
#pragma unroll
            for (int ks = 0; ks < NKS; ++ks) qf[ks] = *(const LAS bf16x8*)(qb + ks * 64);
        }
        unsigned pw[2][4];
#pragma unroll
        for (int jt = 0; jt < 4; ++jt) {
            const bool tv = dir ? (jt >= it) : (jt <= it);
            f32x4 g = (f32x4){0.f, 0.f, 0.f, 0.f};
            if (tv) {
                if (GPRE) g = gcur[jt];
                else {
#pragma unroll
                    for (int ks = 0; ks < NKS; ++ks) { const bf16x8 kf = *(const LAS bf16x8*)(kb_ + jt * 16 * RS + ks * 64); g = mfma16(kf, qf[ks], g); }
                }
                const f32x4 ej = *(const LAS f32x4*)(le + jt * 16 + 4 * fq);
#pragma unroll
                for (int j = 0; j < 4; ++j) { const int jj = jt * 16 + 4 * fq + j; const bool ok = dir ? (jj >= i) : (jj <= i); g[j] = ok ? g[j] * __expf(ei - ej[j]) : 0.f; }
            }
            pw[jt >> 1][(jt & 1) * 2] = cvt_pk_bf16(g[0], g[1]); pw[jt >> 1][(jt & 1) * 2 + 1] = cvt_pk_bf16(g[2], g[3]);
        }
        if (GPRE && has_next) { issue_g(tokn); issue(tokn); }
        const float ex = __expf(ei);
        f32x4 ya[NPW], za[NPW];
#pragma unroll
        for (int pp = 0; pp < NPW; ++pp) {
            const int pt = NPW * ph + pp; ya[pp] = (f32x4){0.f, 0.f, 0.f, 0.f}; za[pp] = (f32x4){0.f, 0.f, 0.f, 0.f};
#pragma unroll
            for (int k2 = 0; k2 < 2; ++k2) {
                const bool skip = dir ? (2 * k2 + 1 < it) : (2 * k2 > it);
                if (!skip) {
                    const LAS unsigned char* vp = vyb + pp * 16 * TS + k2 * 64;
                    u32x2 lo = *(const LAS u32x2*)vp, hi = *(const LAS u32x2*)(vp + 32);
                    if (SSD) { const int j0 = 32 * k2 + 4 * fq; const f32x4 d0 = *(const LAS f32x4*)(ldtv + j0), d1 = *(const LAS f32x4*)(ldtv + j0 + 16);
                        lo.x = cvt_pk_bf16(bf_lo(lo.x) * d0[0], bf_hi(lo.x) * d0[1]); lo.y = cvt_pk_bf16(bf_lo(lo.y) * d0[2], bf_hi(lo.y) * d0[3]);
                        hi.x = cvt_pk_bf16(bf_lo(hi.x) * d1[0], bf_hi(hi.x) * d1[1]); hi.y = cvt_pk_bf16(bf_lo(hi.y) * d1[2], bf_hi(hi.y) * d1[3]); }
                    u32x4 vw; vw.x = lo.x; vw.y = lo.y; vw.z = hi.x; vw.w = hi.y;
                    u32x4 pfr; pfr.x = pw[k2][0]; pfr.y = pw[k2][1]; pfr.z = pw[k2][2]; pfr.w = pw[k2][3];
                    ya[pp] = mfma16(as_bf16x8(vw), as_bf16x8(pfr), ya[pp]);
                }
            }
        }
#pragma unroll
        for (int ks = 0; ks < NKS; ++ks) {
            const bf16x8 qk = GPRE ? *(const LAS bf16x8*)(qb + ks * 64) : qf[ks];
#pragma unroll
            for (int pp = 0; pp < NPW; ++pp) { const bf16x8 sf = *(const LAS bf16x8*)(zb + pp * 16 * RS + ks * 64); za[pp] = mfma16(sf, qk, za[pp]); }
        }
#pragma unroll
        for (int pp = 0; pp < NPW; ++pp) st_bf16x4(Y + (size_t)(tokc + i) * ldy + (NPW * ph + pp) * 16 + 4 * fq, ya[pp] + za[pp] * ex);
        {
            const float eE = __expf(lE[0]);
            bf16x8 vs[NPI][2];
#pragma unroll
            for (int pi = 0; pi < NPI; ++pi)
#pragma unroll
                for (int k2 = 0; k2 < 2; ++k2) { const u32x4 w = *(const LAS u32x4*)(vsb + pi * 64 * TS + k2 * 64); const int j0 = k2 * 32 + fq * 8;
                    const f32x4 t0 = *(const LAS f32x4*)(ldtt + j0), t1 = *(const LAS f32x4*)(ldtt + j0 + 4); u32x4 o;
                    o.x = cvt_pk_bf16(bf_lo(w.x) * t0[0], bf_hi(w.x) * t0[1]); o.y = cvt_pk_bf16(bf_lo(w.y) * t0[2], bf_hi(w.y) * t0[3]);
                    o.z = cvt_pk_bf16(bf_lo(w.z) * t1[0], bf_hi(w.z) * t1[1]); o.w = cvt_pk_bf16(bf_lo(w.w) * t1[2], bf_hi(w.w) * t1[3]);
                    vs[pi][k2] = as_bf16x8(o); }
#pragma unroll
            for (int q = 0; q < NKS; ++q) { const int nt = ph * NKS + q;
                bf16x8 kt[2];
#pragma unroll
                for (int k2 = 0; k2 < 2; ++k2) kt[k2] = *(const LAS bf16x8*)(ktb + q * 16 * TS + k2 * 64);
#pragma unroll
                for (int pi = 0; pi < NPI; ++pi) { sacc[pi][q] = sacc[pi][q] * eE;
#pragma unroll
                    for (int k2 = 0; k2 < 2; ++k2) sacc[pi][q] = mfma16(vs[pi][k2], kt[k2], sacc[pi][q]); }
                if (GPRE && (q & 1)) __builtin_amdgcn_sched_barrier(0);
            }
        }
        __syncthreads();
        if (has_next) {
            put_state(sacc);
            commit();
        }
    }
    if (sfin) {
#pragma unroll
        for (int pi = 0; pi < NPI; ++pi)
#pragma unroll
            for (int q = 0; q < NKS; ++q) { const int nt = ph * NKS + q; *(f32x4*)(sfin + (size_t)(nt * 16 + fr) * ldS + (it + 4 * pi) * 16 + 4 * fq) = sacc[pi][q]; }
    }
}
__device__ __forceinline__ void retg_item(const bf16_t* QR, const bf16_t* KR, float* GP, int c, int h, int it, int lane) {
    const int fr = lane & 15, fq = lane >> 4, tokc = c * 64;
    bf16x8 qf[8];
#pragma unroll
    for (int ks = 0; ks < 8; ++ks) qf[ks] = *(const bf16x8*)(QR + (size_t)(tokc + it * 16 + fr) * 1024 + h * 256 + ks * 32 + fq * 8);
#pragma unroll
    for (int jt = 0; jt < 4; ++jt) { f32x4 g = (f32x4){0.f, 0.f, 0.f, 0.f};
#pragma unroll
        for (int ks = 0; ks < 8; ++ks) { const bf16x8 kf = *(const bf16x8*)(KR + (size_t)(tokc + jt * 16 + fr) * 1024 + h * 256 + ks * 32 + fq * 8); g = mfma16(kf, qf[ks], g); }
        *(f32x4*)(GP + ((size_t)(((c * 4 + h) * 4 + it) * 4 + jt) * 64 + lane) * 4) = g; }
}
__device__ __forceinline__ void in1_phase(const Params& p, LAS unsigned char* lds, const EpiIn1& e) {
    unsigned char* ws = p.ws; const bf16_t* H = (const bf16_t*)(ws + O_H); const bf16_t* W = (const bf16_t*)(ws + O_W1IN);
    const int bx = (int)blockIdx.x, G = (int)gridDim.x; const bool fused = G == 256;
    for (int k = 0;; ++k) {
        int pm, pn; bool ok;
        if (fused) { ok = k < 3;
            if (bx < 192) { pm = bx >> 2; pn = 4 * k + (bx & 3); }
            else { const int t = (bx - 192) * 3 + k; pm = t >> 2; pn = 12 + (t & 3); } }
        else ok = tile_of(k * G + bx, T / BM, 16, pm, pn);
        if (!ok) break;
        gemm_tile(lds, H, W, 1024, pm * BM, pn * BM, e);
        if (fused && bx < 192 && k == 1) {
            const bf16_t* QR = (const bf16_t*)(ws + O_QR); const bf16_t* KR = (const bf16_t*)(ws + O_KR); float* GP = (float*)(ws + O_GP);
            const int wv = threadIdx.x >> 6, lane = threadIdx.x & 63;
            for (int u = wv; u < 16; u += 8) retg_item(QR, KR, GP, pm * 4 + (u >> 2), bx & 3, u & 3, lane);
        }
    }
}
__device__ __forceinline__ void retg_phase(const Params& p) {
    unsigned char* ws = p.ws; const bf16_t* QR = (const bf16_t*)(ws + O_QR); const bf16_t* KR = (const bf16_t*)(ws + O_KR); float* GP = (float*)(ws + O_GP);
    const int lane = threadIdx.x & 63, gw = blockIdx.x * 8 + (threadIdx.x >> 6), nwv = gridDim.x * 8;
    for (int idx = gw; idx < 192 * 4 * 4; idx += nwv) retg_item(QR, KR, GP, idx >> 4, (idx >> 2) & 3, idx & 3, lane);
}
__device__ __forceinline__ int next_item(unsigned* ctr, LAS unsigned char* lds) {
    LAS int* slot = (LAS int*)(lds + 896);
    if (threadIdx.x == 0) slot[0] = (int)atomicAdd(ctr, 1u);
    __syncthreads();
    const int v = slot[0];
    __syncthreads();
    return v;
}
__device__ __forceinline__ void ssd_phase(const Params& p, LAS unsigned char* lds, int rep) {
    unsigned char* ws = p.ws; unsigned* ctr = (unsigned*)(ws + O_CTL) + 0 + 2 * rep;
    const bf16_t* XC = (const bf16_t*)(ws + O_XC); const bf16_t* XT = (const bf16_t*)(ws + O_XT); bf16_t* YS = (bf16_t*)(ws + O_YS); const float* DT = (const float*)(ws + O_DT);
    for (;;) {
        const int it = next_item(ctr, lds); if (it >= 128 + 1024) break;
        int b, dir, h, tok0, nch; const float* s0 = nullptr; float* sfin = nullptr;
        if (it < 128) { b = it >> 5; dir = (it >> 4) & 1; h = it & 15; tok0 = TC + b * 1024; nch = 16; s0 = p.in[4] + (size_t)((b * 2 + dir) * 16 + h) * 128 * 64; }
        else { const int u = it - 128; b = u >> 5; dir = (u >> 4) & 1; h = u & 15; tok0 = b * 256; nch = 4; sfin = p.out + OUT_SSD + (size_t)((b * 2 + dir) * 16 + h) * 128 * 64; }
        const int g = h >> 3;
        scan_item<128, true, 64, false>(lds, XC + 1280 + g * 128, XC + 1024 + g * 128, 1536, XT + (size_t)(1024 + g * 128) * T, XT + (size_t)(h * 64) * T, tok0, nch, dir, s0, sfin, 64,
                             YS + (size_t)dir * T * 1024 + h * 64, 1024, DT + dir * 16 + h, p.in[18][dir * 16 + h], -__expf(p.in[17][dir * 16 + h]), nullptr);
    }
}
__device__ __forceinline__ void ret_phase(const Params& p, LAS unsigned char* lds, int rep) {
    unsigned char* ws = p.ws; unsigned* ctr = (unsigned*)(ws + O_CTL) + 1 + 2 * rep;
    const bf16_t* QR = (const bf16_t*)(ws + O_QR); const bf16_t* KR = (const bf16_t*)(ws + O_KR); const bf16_t* KRT = (const bf16_t*)(ws + O_KRT); const bf16_t* VRT = (const bf16_t*)(ws + O_VRT);
    bf16_t* YR = (bf16_t*)(ws + O_YR); const float* GP = (const float*)(ws + O_GP);
    int first_tile = 0;
    for (;;) {
        const int it = next_item(ctr, lds); if (it >= 128 + 1024) { first_tile = it; break; }
        int b, dir, h, sl, tok0, nch; const float* s0 = nullptr; float* sfin = nullptr;
        if (it < 128) { b = it >> 5; dir = (it >> 4) & 1; h = (it >> 2) & 3; sl = it & 3; tok0 = TC + b * 1024; nch = 16; s0 = p.in[5] + (size_t)((b * 2 + dir) * 4 + h) * 256 * 512 + sl * 128; }
        else { const int u = it - 128; b = u >> 5; dir = (u >> 4) & 1; h = (u >> 2) & 3; sl = u & 3; tok0 = b * 256; nch = 4; sfin = p.out + OUT_RET + (size_t)((b * 2 + dir) * 4 + h) * 256 * 512 + sl * 128; }
        const float x = p.in[30][dir * 4 + h]; const float lg = -softplusf(-x);
        scan_item<256, false, 128, true>(lds, QR + h * 256, KR + h * 256, 1024, KRT + (size_t)(h * 256) * T, VRT + (size_t)(h * 512 + sl * 128) * T, tok0, nch, dir, s0, sfin, 512,
                              YR + (size_t)dir * T * 2048 + h * 512 + sl * 128, 2048, nullptr, 0.f, lg, GP + (size_t)h * 16 * 256);
    }
    { const EpiIn1 e{(bf16_t*)(ws + O_QR), (bf16_t*)(ws + O_KR), (bf16_t*)(ws + O_KRT), (bf16_t*)(ws + O_VRT), (bf16_t*)(ws + O_GR)};
      for (int it = first_tile; it < 128 + 1024 + 384; it = next_item(ctr, lds)) { const int t = it - (128 + 1024);
          gemm_tile(lds, (const bf16_t*)(ws + O_H), (const bf16_t*)(ws + O_W1IN), 1024, (t >> 3) * 256, 4096 + (t & 7) * 256, e); } }
}

__device__ __forceinline__ void ssd_gate_phase(const Params& p) {
    unsigned char* ws = p.ws; const bf16_t* YS = (const bf16_t*)(ws + O_YS); const bf16_t* XC = (const bf16_t*)(ws + O_XC); const bf16_t* Z = (const bf16_t*)(ws + O_Z); bf16_t* MIX = (bf16_t*)(ws + O_MIX);
    const float* dsk = p.in[19]; const float* nw = p.in[20];
    const int lane = threadIdx.x & 63, gw = blockIdx.x * 8 + (threadIdx.x >> 6), nwv = gridDim.x * 8;
    for (int it = gw; it < T * 2; it += nwv) {
        const int tok = it >> 1, g = it & 1, ch = g * 512 + lane * 8;
        float a[8], b[8], x[8], z[8];
        unpack8(*(const u32x4*)(YS + (size_t)tok * 1024 + ch), a); unpack8(*(const u32x4*)(YS + (size_t)(T + tok) * 1024 + ch), b);
        unpack8(*(const u32x4*)(XC + (size_t)tok * 1536 + ch), x); unpack8(*(const u32x4*)(Z + (size_t)tok * 1024 + ch), z);
        const float d = dsk[ch >> 6]; float ss = 0.f;
#pragma unroll
        for (int e = 0; e < 8; ++e) { a[e] = (a[e] + b[e] + d * x[e]) * siluf(z[e]); ss += a[e] * a[e]; }
        ss = wave_sum(ss); const float rstd = rsqrtf(ss * (1.f / 512.f) + 1e-6f);
        const f32x4 w0 = *(const f32x4*)(nw + ch), w1 = *(const f32x4*)(nw + ch + 4);
        u32x4 o; o.x = cvt_pk_bf16(a[0] * rstd * w0[0], a[1] * rstd * w0[1]); o.y = cvt_pk_bf16(a[2] * rstd * w0[2], a[3] * rstd * w0[3]);
        o.z = cvt_pk_bf16(a[4] * rstd * w1[0], a[5] * rstd * w1[1]); o.w = cvt_pk_bf16(a[6] * rstd * w1[2], a[7] * rstd * w1[3]);
        *(u32x4*)(MIX + (size_t)tok * 1536 + 512 + ch) = o;
    }
}
__device__ __forceinline__ void ret_gate_phase(const Params& p) {
    unsigned char* ws = p.ws; const bf16_t* YR = (const bf16_t*)(ws + O_YR); const bf16_t* GR = (const bf16_t*)(ws + O_GR); bf16_t* RG = (bf16_t*)(ws + O_RG);
    const float* nw = p.in[31];
    const int lane = threadIdx.x & 63, gw = blockIdx.x * 8 + (threadIdx.x >> 6), nwv = gridDim.x * 8;
    for (int it = gw; it < T * 4; it += nwv) {
        const int tok = it >> 2, h = it & 3, ch = h * 512 + lane * 8;
        float a[8], b[8], gt[8];
        unpack8(*(const u32x4*)(YR + (size_t)tok * 2048 + ch), a); unpack8(*(const u32x4*)(YR + (size_t)(T + tok) * 2048 + ch), b); unpack8(*(const u32x4*)(GR + (size_t)tok * 2048 + ch), gt);
        float ss = 0.f;
#pragma unroll
        for (int e = 0; e < 8; ++e) { a[e] += b[e]; ss += a[e] * a[e]; }
        ss = wave_sum(ss); const float rstd = rsqrtf(ss * (1.f / 512.f) + 1e-6f);
        const f32x4 w0 = *(const f32x4*)(nw + ch), w1 = *(const f32x4*)(nw + ch + 4);
        float o[8];
#pragma unroll
        for (int e = 0; e < 8; ++e) o[e] = a[e] * rstd * (e < 4 ? w0[e] : w1[e - 4]) * siluf(gt[e]);
        u32x4 ow; ow.x = cvt_pk_bf16(o[0], o[1]); ow.y = cvt_pk_bf16(o[2], o[3]); ow.z = cvt_pk_bf16(o[4], o[5]); ow.w = cvt_pk_bf16(o[6], o[7]);
        *(u32x4*)(RG + (size_t)tok * 2048 + ch) = ow;
    }
}

#define XB_TMO      128
#define XB_XCNT(j)  (256  + 64 * (j))
#define XB_XSUB(j)  (1280 + 64 * (j))
#define XB_XGEN(j)  (2304 + 64 * (j))
#define XB_TOP      3328
#define XB_TOPGEN   3392
#define XCD_BAR_WORDS 3456
#define XB_SPIN_CAP (1u << 18)
__device__ __forceinline__ unsigned xb_ld(unsigned* p)              { return __hip_atomic_load(p, __ATOMIC_RELAXED, __HIP_MEMORY_SCOPE_AGENT); }
__device__ __forceinline__ unsigned xb_add(unsigned* p, unsigned v) { return __hip_atomic_fetch_add(p, v, __ATOMIC_RELAXED, __HIP_MEMORY_SCOPE_AGENT); }
__device__ __forceinline__ unsigned xb_xcc_id() { return (unsigned)__builtin_amdgcn_s_getreg((3 << 11) | 20) & 0xFu; }
#define XB_SPIN(cond, bar) do { unsigned _sp = 0; while (cond) { __builtin_amdgcn_s_sleep(1); \
    if ((++_sp & 255u) == 0u) { if (xb_ld(&(bar)[XB_TMO])) break; if (_sp > XB_SPIN_CAP) { atomicAdd(&(bar)[XB_TMO], 1u); break; } } } } while (0)
struct XcdBarrier { unsigned* bar; unsigned x; volatile LAS unsigned* st; };
__device__ __forceinline__ XcdBarrier xcd_barrier_post(unsigned* bar, volatile LAS unsigned* st) {
    XcdBarrier b; b.bar = bar; b.x = xb_xcc_id(); b.st = st;
    if (threadIdx.x == 0) (void)xb_add(&bar[XB_XCNT(b.x)], 1u);
    return b;
}
__device__ __forceinline__ void xcd_barrier_complete(unsigned* bar, unsigned x, unsigned& nloc, unsigned& nx) {
    const unsigned G = gridDim.x * gridDim.y * gridDim.z;
    unsigned sum, cnt, mine, sp = 0u;
    for (;;) {
        sum = 0u; cnt = 0u; mine = 0u;
#pragma unroll
        for (unsigned j = 0; j < 16; ++j) { const unsigned c = xb_ld(&bar[XB_XCNT(j)]); sum += c; cnt += (c > 0u) ? 1u : 0u; mine = (j == x) ? c : mine; }
        if (sum == G) break;
        __builtin_amdgcn_s_sleep(1);
        if ((++sp & 255u) == 0u) { if (xb_ld(&bar[XB_TMO])) break; if (sp > XB_SPIN_CAP) { atomicAdd(&bar[XB_TMO], 1u); break; } }
    }
    nloc = mine > 0u ? mine : 1u; nx = cnt > 0u ? cnt : 1u;
}
__device__ __forceinline__ void xcd_barrier(const XcdBarrier& b) {
    asm volatile("s_waitcnt vmcnt(0)" ::: "memory");
    __syncthreads();
    if (threadIdx.x == 0) {
        unsigned* bar = b.bar;
        __builtin_amdgcn_s_waitcnt(0);
        unsigned nloc = b.st[0], nx = b.st[1];
        if (nloc == 0u) { xcd_barrier_complete(bar, b.x, nloc, nx); b.st[0] = nloc; b.st[1] = nx; }
        const unsigned old = xb_add(&bar[XB_XSUB(b.x)], 1u);
        const unsigned gen = old / nloc;
        if (old + 1u == (gen + 1u) * nloc) {
            __builtin_amdgcn_fence(__ATOMIC_RELEASE, "agent");
            asm volatile("s_waitcnt vmcnt(0)" ::: "memory");
            const unsigned og = xb_add(&bar[XB_TOP], 1u);
            const unsigned tg = og / nx;
            if (og + 1u == (tg + 1u) * nx) xb_add(&bar[XB_TOPGEN], 1u);
            else XB_SPIN(xb_ld(&bar[XB_TOPGEN]) == tg, bar);
            __builtin_amdgcn_fence(__ATOMIC_ACQUIRE, "agent");
            xb_add(&bar[XB_XGEN(b.x)], 1u);
            asm volatile("s_waitcnt vmcnt(0)" ::: "memory");
        } else {
            XB_SPIN(xb_ld(&bar[XB_XGEN(b.x)]) == gen, bar);
            __builtin_amdgcn_fence(__ATOMIC_ACQUIRE, "agent");
            asm volatile("s_waitcnt vmcnt(0)" ::: "memory");
        }
    }
    __syncthreads();
}

constexpr int N_PHASES = 19;
__global__ void __launch_bounds__(NTHR) fwd_megakernel(Params p_arg) {
    const Params& p = *(const Params*)__builtin_amdgcn_kernarg_segment_ptr();
    extern __shared__ __attribute__((aligned(16))) unsigned char lds_raw[];
    LAS unsigned char* lds = (LAS unsigned char*)lds_raw;
    cg::grid_group grid = cg::this_grid();
    if (threadIdx.x < 4) ((LAS unsigned*)(lds + LDS_XB_OFF))[threadIdx.x] = 0u;
    __syncthreads();
    (void)xcd_barrier_post((unsigned*)(p.ws + O_CTL) + 256, (volatile LAS unsigned*)(lds + LDS_XB_OFF));
    unsigned char* ws = p.ws;
    float* MOD = (float*)(ws + O_MOD); bf16_t* H = (bf16_t*)(ws + O_H); float* XA = (float*)(ws + O_XA);
#ifdef ONLY_PHASE
#define PH_ON(k) ((k) == ONLY_PHASE)
#else
#define PH_ON(k) (p.ph_lo <= (k) && (k) < p.ph_hi)
#endif
#ifndef PROBE_MASK
#define PROBE_MASK 0
#endif
#define PH_BEGIN(k) if (PH_ON(k)) { for (int rep = 0; rep <= ((PROBE_MASK >> (k)) & 1); ++rep) {
#define PH_END(k) } } if (p.ph_lo <= (k) && (k) + 1 < p.ph_hi) { if ((k) == 0 && p.ph_lo < 0) grid.sync(); else { XcdBarrier xb_; xb_.bar = (unsigned*)(p.ws + O_CTL) + 256; xb_.x = xb_xcc_id(); xb_.st = (volatile LAS unsigned*)(lds + LDS_XB_OFF); xcd_barrier(xb_); } }
    PH_BEGIN(0) prep_phase(p, lds, 0, (int)blockIdx.x, (int)gridDim.x);
        if (gridDim.x <= 192) { prep_phase(p, lds, 1, (int)blockIdx.x, (int)gridDim.x); prep_phase(p, lds, 2, (int)blockIdx.x, (int)gridDim.x); } PH_END(0)
    PH_BEGIN(1) norm_phase(p.in[0], p.in[1], p.in[8], MOD, 0, 1024, H, nullptr); PH_END(1)
    PH_BEGIN(2) EpiIn0 e{(bf16_t*)(ws + O_Q0), (bf16_t*)(ws + O_K0), (bf16_t*)(ws + O_V0T), (bf16_t*)(ws + O_Z), (bf16_t*)(ws + O_XBC), (float*)(ws + O_DT), p.out + OUT_K, p.out + OUT_V};
        gemm_phase(lds, H, (const bf16_t*)(ws + O_W0IN), 4096, 1024, e); PH_END(2)
    PH_BEGIN(3) conv_phase(p, lds); na_phase(p, lds); PH_END(3)
    PH_BEGIN(4) ssd_phase(p, lds, rep); PH_END(4)
    PH_BEGIN(5) ssd_gate_phase(p); PH_END(5)
    PH_BEGIN(6) EpiRes e{p.in[0], p.in[1], XA, MOD + 2048}; gemm_phase(lds, (const bf16_t*)(ws + O_MIX), (const bf16_t*)(ws + O_W0OUT), 1024, 1536, e, &p, gridDim.x > 192 ? 1 : 0); PH_END(6)
    PH_BEGIN(7) norm_phase(XA, XA + (size_t)TC * 1024, p.in[9], MOD, 3072, 4096, H, nullptr); PH_END(7)
    PH_BEGIN(8) EpiSwiglu e{(bf16_t*)(ws + O_HID)}; gemm_phase(lds, H, (const bf16_t*)(ws + O_W0UP), 5632, 1024, e); PH_END(8)
    PH_BEGIN(9) EpiRes e{XA, XA + (size_t)TC * 1024, XA, MOD + 5120}; gemm_phase(lds, (const bf16_t*)(ws + O_HID), (const bf16_t*)(ws + O_W0DN), 1024, 2816, e, &p, gridDim.x > 192 ? 2 : 0); PH_END(9)
    PH_BEGIN(10) norm_phase(XA, XA + (size_t)TC * 1024, p.in[24], MOD + 5 * 6144, 0, 1024, H, nullptr); PH_END(10)
    PH_BEGIN(11) EpiIn1 e{(bf16_t*)(ws + O_QR), (bf16_t*)(ws + O_KR), (bf16_t*)(ws + O_KRT), (bf16_t*)(ws + O_VRT), (bf16_t*)(ws + O_GR)};
        in1_phase(p, lds, e);
        if (gridDim.x != 256) { XcdBarrier xb_; xb_.bar = (unsigned*)(p.ws + O_CTL) + 256; xb_.x = xb_xcc_id(); xb_.st = (volatile LAS unsigned*)(lds + LDS_XB_OFF); xcd_barrier(xb_); retg_phase(p); } PH_END(11)
    PH_BEGIN(12) ret_phase(p, lds, rep); PH_END(12)
    PH_BEGIN(13) ret_gate_phase(p); PH_END(13)
    PH_BEGIN(14) EpiRes e{XA, XA + (size_t)TC * 1024, XA, MOD + 5 * 6144 + 2048}; gemm_phase(lds, (const bf16_t*)(ws + O_RG), (const bf16_t*)(ws + O_W1OUT), 1024, 2048, e); PH_END(14)
    PH_BEGIN(15) norm_phase(XA, XA + (size_t)TC * 1024, p.in[25], MOD + 5 * 6144, 3072, 4096, H, nullptr); PH_END(15)
    PH_BEGIN(16) EpiSwiglu e{(bf16_t*)(ws + O_HID)}; gemm_phase(lds, H, (const bf16_t*)(ws + O_W1UP), 5632, 1024, e); PH_END(16)
    PH_BEGIN(17) EpiRes e{XA, XA + (size_t)TC * 1024, XA, MOD + 5 * 6144 + 5120}; gemm_phase(lds, (const bf16_t*)(ws + O_HID), (const bf16_t*)(ws + O_W1DN), 1024, 2816, e); PH_END(17)
    PH_BEGIN(18) norm_phase(XA, XA + (size_t)TC * 1024, p.in[35], nullptr, 0, 0, nullptr, p.out + OUT_Y); PH_END(18)
}

extern "C" void kernel_launch(void* const* d_in, const int* in_sizes, int n_in, void* d_out, int out_size, void* d_ws, size_t ws_size, hipStream_t stream) {
    static int grid_blocks = 0;
    if (grid_blocks == 0) {
        if (n_in != 36 || ws_size < WS_END) { fprintf(stderr, "kernel_launch: unexpected n_in %d / ws %zu (need %zu)\n", n_in, ws_size, (size_t)WS_END); grid_blocks = -1; return; }
        int dev = 0, cus = 0, per_cu = 0;
        hipGetDevice(&dev); hipDeviceGetAttribute(&cus, hipDeviceAttributeMultiprocessorCount, dev);
        if (hipFuncSetAttribute((const void*)fwd_megakernel, hipFuncAttributeMaxDynamicSharedMemorySize, LDS_BYTES) != hipSuccess) { fprintf(stderr, "kernel_launch: hipFuncSetAttribute failed\n"); grid_blocks = -1; return; }
        if (hipOccupancyMaxActiveBlocksPerMultiprocessor(&per_cu, (const void*)fwd_megakernel, NTHR, LDS_BYTES) != hipSuccess || per_cu < 1) { fprintf(stderr, "kernel_launch: occupancy query failed (%d)\n", per_cu); grid_blocks = -1; return; }
        grid_blocks = cus * per_cu;
    }
    if (grid_blocks < 0) return;
    hipMemsetAsync((char*)d_ws + O_CTL, 0, 16384, stream);
    Params p{};
    for (int i = 0; i < 36; ++i) p.in[i] = (const float*)d_in[i];
    p.out = (float*)d_out; p.ws = (unsigned char*)d_ws;
#if N_SPLIT
    for (int ph = 0; ph < N_PHASES; ++ph) { p.ph_lo = ph; p.ph_hi = ph + 1; void* args[] = {&p};
        hipError_t e = hipLaunchCooperativeKernel((void*)fwd_megakernel, dim3(grid_blocks), dim3(NTHR), args, LDS_BYTES, stream);
        if (e != hipSuccess) { fprintf(stderr, "launch failed: %s\n", hipGetErrorString(e)); break; } }
#else
    p.ph_lo = 0; p.ph_hi = N_PHASES; void* args[] = {&p};
    hipError_t e = hipLaunchCooperativeKernel((void*)fwd_megakernel, dim3(grid_blocks), dim3(NTHR), args, LDS_BYTES, stream);
    if (e != hipSuccess) fprintf(stderr, "cooperative launch failed: %s (grid %d)\n", hipGetErrorString(e), grid_blocks);
#endif
}
```

```cpp
#include <hip/hip_runtime.h>
#include <hip/hip_cooperative_groups.h>
#include <cstdio>
#include <cstdint>
namespace cg = cooperative_groups;

#ifndef N_SPLIT
#define N_SPLIT 0
#endif

#define LAS __attribute__((address_space(3)))
typedef unsigned short bf16_t;
typedef short bf16x8 __attribute__((ext_vector_type(8)));
typedef float f32x4 __attribute__((ext_vector_type(4)));
typedef unsigned u32x4 __attribute__((ext_vector_type(4)));
typedef unsigned u32x2 __attribute__((ext_vector_type(2)));

constexpr int T = 12288, TC = 8192, DM = 1024;
constexpr int NTHR = 512;
constexpr int LDS_BYTES = 163840;
constexpr int LDS_XB_OFF = LDS_BYTES - 16;
constexpr int FFN = 2816;

constexpr size_t al256(size_t x) { return (x + 255) & ~(size_t)255; }
constexpr size_t O_CTL   = 0;
constexpr size_t O_MOD   = 16384;
constexpr size_t O_W0IN  = al256(O_MOD + 2 * 5 * 6144 * 4);
constexpr size_t O_W0OUT = O_W0IN + (size_t)4352 * 1024 * 2;
constexpr size_t O_W0UP  = O_W0OUT + (size_t)1024 * 1536 * 2;
constexpr size_t O_W0DN  = O_W0UP + (size_t)5632 * 1024 * 2;
constexpr size_t O_W1IN  = O_W0DN + (size_t)1024 * 2816 * 2;
constexpr size_t O_W1OUT = O_W1IN + (size_t)6144 * 1024 * 2;
constexpr size_t O_W1UP  = O_W1OUT + (size_t)1024 * 2048 * 2;
constexpr size_t O_W1DN  = O_W1UP + (size_t)5632 * 1024 * 2;
constexpr size_t O_CK    = O_W1DN + (size_t)1024 * 2816 * 2;
constexpr size_t O_CVT   = O_CK + (size_t)4 * 256 * 512 * 2;
constexpr size_t O_H     = O_CVT + (size_t)4 * 512 * 256 * 2;
constexpr size_t O_XA    = O_H + (size_t)T * 1024 * 2;
constexpr size_t O_Q0    = O_XA + (size_t)T * 1024 * 4;
constexpr size_t O_K0    = O_Q0 + (size_t)T * 512 * 2;
constexpr size_t O_V0T   = O_K0 + (size_t)T * 512 * 2;
constexpr size_t O_Z     = O_V0T + (size_t)T * 512 * 2;
constexpr size_t O_XBC   = O_Z + (size_t)T * 1024 * 2;
constexpr size_t O_DT    = O_XBC + (size_t)T * 1536 * 2;
constexpr size_t O_XC    = O_DT + (size_t)T * 32 * 4;
constexpr size_t O_XT    = O_XC + (size_t)T * 1536 * 2;
constexpr size_t O_YS    = O_XT + (size_t)1280 * T * 2;
constexpr size_t O_MIX   = O_YS + (size_t)2 * T * 1024 * 2;
constexpr size_t O_HID   = O_MIX + (size_t)T * 1536 * 2;
constexpr size_t O_QR    = O_HID + (size_t)T * 2816 * 2;
constexpr size_t O_KR    = O_QR + (size_t)T * 1024 * 2;
constexpr size_t O_KRT   = O_KR + (size_t)T * 1024 * 2;
constexpr size_t O_VRT   = O_KRT + (size_t)T * 1024 * 2;
constexpr size_t O_GR    = O_VRT + (size_t)T * 2048 * 2;
constexpr size_t O_YR    = O_GR + (size_t)T * 2048 * 2;
constexpr size_t O_RG    = O_YR + (size_t)2 * T * 2048 * 2;
constexpr size_t O_GP    = O_RG + (size_t)T * 2048 * 2;
constexpr size_t WS_END  = O_GP + (size_t)192 * 4 * 16 * 256 * 4;

constexpr size_t OUT_Y = 0, OUT_K = (size_t)T * 1024, OUT_V = OUT_K + (size_t)TC * 512, OUT_SSD = OUT_V + (size_t)TC * 512,
                 OUT_RET = OUT_SSD + (size_t)32 * 2 * 16 * 128 * 64;

struct Params { const float* in[36]; float* out; unsigned char* ws; int ph_lo, ph_hi; };

typedef float f32x2 __attribute__((ext_vector_type(2)));
typedef __bf16 nbf16x2 __attribute__((ext_vector_type(2)));
__device__ __forceinline__ unsigned cvt_pk_bf16(float lo, float hi) { const f32x2 v = {lo, hi}; const nbf16x2 b = __builtin_convertvector(v, nbf16x2); return __builtin_bit_cast(unsigned, b); }
__device__ __forceinline__ bf16_t f2bf(float x) { return (bf16_t)(cvt_pk_bf16(x, 0.f) & 0xffffu); }
__device__ __forceinline__ float bf_lo(unsigned w) { return __uint_as_float(w << 16); }
__device__ __forceinline__ float bf_hi(unsigned w) { return __uint_as_float(w & 0xffff0000u); }
__device__ __forceinline__ float bf2f(bf16_t b) { return __uint_as_float((unsigned)b << 16); }
__device__ __forceinline__ void unpack8(u32x4 w, float (&x)[8]) { x[0] = bf_lo(w.x); x[1] = bf_hi(w.x); x[2] = bf_lo(w.y); x[3] = bf_hi(w.y); x[4] = bf_lo(w.z); x[5] = bf_hi(w.z); x[6] = bf_lo(w.w); x[7] = bf_hi(w.w); }
__device__ __forceinline__ float siluf(float x) { return x * __builtin_amdgcn_rcpf(1.f + __expf(-x)); }
__device__ __forceinline__ float softplusf(float x) { return x > 20.f ? x : log1pf(__expf(x)); }
__device__ __forceinline__ bf16x8 as_bf16x8(u32x4 v) { return __builtin_bit_cast(bf16x8, v); }
__device__ __forceinline__ f32x4 mfma16(bf16x8 a, bf16x8 b, f32x4 c) { return __builtin_amdgcn_mfma_f32_16x16x32_bf16(a, b, c, 0, 0, 0); }
__device__ __forceinline__ float wave_sum(float v) {
#pragma unroll
    for (int o = 32; o >= 1; o >>= 1) v += __shfl_xor(v, o);
    return v;
}

constexpr int BM = 256, BK = 64, HALF = 128, HTB = HALF * BK * 2;
__device__ __forceinline__ int lds_byte(int r, int c) { const int st = (r >> 4) * 2 + (c >> 5), rr = r & 15, cc = c & 31, ob = rr * 64 + cc * 2; return st * 1024 + (ob ^ (((ob >> 9) & 1) << 5)); }
__device__ __forceinline__ void stage_rc(int b, int& R, int& C) { const int st = b / 1024, sb = b % 1024, swz = sb ^ (((sb >> 9) & 1) << 5); R = (st >> 1) * 16 + swz / 64; C = (st & 1) * 32 + (swz % 64) / 2; }

__device__ __forceinline__ bool tile_of(int L, int nM, int nN, int& pm, int& pn) {
    const int nwg = nM * nN; if (L >= nwg) return false;
    int wgid = L; { const int q = nwg / 8, r = nwg % 8, xcd = wgid % 8, off = wgid / 8; wgid = (xcd < r ? xcd * (q + 1) : r * (q + 1) + (xcd - r) * q) + off; }
    const int nig = 8 * nN, gid = wgid / nig, fm = gid * 8, gsz = (nM - fm) < 8 ? (nM - fm) : 8;
    pm = fm + ((wgid % nig) % gsz); pn = (wgid % nig) / gsz; return true;
}

template <class Epi>
__device__ __forceinline__ void gemm_tile(LAS unsigned char* lds, const bf16_t* __restrict__ A, const bf16_t* __restrict__ Bt, const int K, const int brow, const int bcol, const Epi& epi) {
    const int tid = threadIdx.x, wid = __builtin_amdgcn_readfirstlane(tid >> 6), lane = tid & 63, wr = wid >> 2, wc = wid & 3, fr = lane & 15, fq = lane >> 4;
    unsigned voff[2], voffB[2];
#pragma unroll
    for (int i = 0; i < 2; ++i) { int R, C; stage_rc(tid * 16 + i * 8192, R, C); voff[i] = (unsigned)(R * K + C) * 2u;
        const int rho = R & 31, Rb = (R & ~31) + 8 * ((rho & 15) >> 2) + 4 * (rho >> 4) + (rho & 3); voffB[i] = (unsigned)(Rb * K + C) * 2u; }
    const unsigned ldsw = (unsigned)wid * 1024u;
    const int aoff = lds_byte(wr * 64 + fr, fq * 8), boff = lds_byte(wc * 32 + fr, fq * 8);
    const char* cA = (const char*)(A + (size_t)brow * K); const char* cB = (const char*)(Bt + (size_t)bcol * K);
    const size_t kstep = (size_t)BK * 2, hstep = (size_t)HALF * K * 2;
#define SA(b, h) (((b) * 2 + (h)) * HTB)
#define SB(b, h) ((4 + (b) * 2 + (h)) * HTB)
#define STAGE(bufoff, gbase) do { _Pragma("unroll") for (int _i = 0; _i < 2; ++_i) \
        __builtin_amdgcn_global_load_lds((const unsigned*)((gbase) + ((bufoff) >= 4 * HTB ? voffB[_i] : voff[_i])), (LAS unsigned*)(lds + (bufoff) + ldsw + _i * 8192), 16, 0, 0); } while (0)
#define LDA(dst, b, h) do { _Pragma("unroll") for (int m = 0; m < 4; ++m) _Pragma("unroll") for (int k = 0; k < 2; ++k) dst[m][k] = *(const LAS bf16x8*)(lds + SA(b, h) + aoff + m * 2048 + k * 1024); } while (0)
#define LDB(dst, b, h) do { _Pragma("unroll") for (int n = 0; n < 2; ++n) _Pragma("unroll") for (int k = 0; k < 2; ++k) dst[n][k] = *(const LAS bf16x8*)(lds + SB(b, h) + boff + n * 2048 + k * 1024); } while (0)
#define MMA(ai, bj, At, Bt_) do { __builtin_amdgcn_s_setprio(1); _Pragma("unroll") for (int m = 0; m < 4; ++m) _Pragma("unroll") for (int n = 0; n < 2; ++n) _Pragma("unroll") for (int k = 0; k < 2; ++k) \
        acc[ai][bj][m][n] = __builtin_amdgcn_mfma_f32_16x16x32_bf16(Bt_[n][k], At[m][k], acc[ai][bj][m][n], 0, 0, 0); __builtin_amdgcn_s_setprio(0); } while (0)
#define WAIT_V(n) asm volatile("s_waitcnt vmcnt(" #n ")" ::: "memory")
#define WAIT_L(n) asm volatile("s_waitcnt lgkmcnt(" #n ")" ::: "memory")
#define BAR __builtin_amdgcn_s_barrier()
#define SCHED __builtin_amdgcn_sched_barrier(0)
    f32x4 acc[2][2][4][2];
#pragma unroll
    for (int a = 0; a < 2; ++a)
#pragma unroll
        for (int b = 0; b < 2; ++b)
#pragma unroll
            for (int m = 0; m < 4; ++m)
#pragma unroll
                for (int n = 0; n < 2; ++n) acc[a][b][m][n] = (f32x4){0.f, 0.f, 0.f, 0.f};
    bf16x8 At[4][2], B0[2][2], B1[2][2];
    const int nt = K / BK;
    STAGE(SB(0, 0), cB); STAGE(SA(0, 0), cA); STAGE(SB(0, 1), cB + hstep); STAGE(SA(0, 1), cA + hstep);
    if (wr == 1) BAR;
    WAIT_V(4); BAR;
    STAGE(SB(1, 0), cB + kstep); STAGE(SA(1, 0), cA + kstep); STAGE(SB(1, 1), cB + hstep + kstep);
    WAIT_V(6); BAR;
    for (int t = 0; t < nt - 2; t += 2) {
        const char* a1 = cA + (size_t)(t + 1) * kstep; const char* a2 = cA + (size_t)(t + 2) * kstep; const char* b2 = cB + (size_t)(t + 2) * kstep;
        const char* a3 = a2 + kstep; const char* b3 = b2 + kstep;
        LDB(B0, 0, 0); SCHED; LDA(At, 0, 0); STAGE(SA(1, 1), a1 + hstep);
        WAIT_L(8); BAR; WAIT_L(0); MMA(0, 0, At, B0); BAR; SCHED;
        LDB(B1, 0, 1); STAGE(SB(0, 0), b2);
        BAR; WAIT_L(0); MMA(0, 1, At, B1); BAR;
        LDA(At, 0, 1); STAGE(SA(0, 0), a2);
        BAR; WAIT_L(0); MMA(1, 0, At, B0); BAR; SCHED;
        STAGE(SB(0, 1), b2 + hstep);
        WAIT_V(6); BAR; MMA(1, 1, At, B1); BAR;
        LDB(B0, 1, 0); SCHED; LDA(At, 1, 0); STAGE(SA(0, 1), a2 + hstep);
        WAIT_L(8); BAR; WAIT_L(0); MMA(0, 0, At, B0); BAR; SCHED;
        LDB(B1, 1, 1); STAGE(SB(1, 0), b3);
        BAR; WAIT_L(0); MMA(0, 1, At, B1); BAR;
        LDA(At, 1, 1); STAGE(SA(1, 0), a3);
        BAR; WAIT_L(0); MMA(1, 0, At, B0); BAR; SCHED;
        STAGE(SB(1, 1), b3 + hstep);
        WAIT_V(6); BAR; MMA(1, 1, At, B1); BAR;
    }
    { const char* a1 = cA + (size_t)(nt - 1) * kstep;
      LDB(B0, 0, 0); LDA(At, 0, 0); STAGE(SA(1, 1), a1 + hstep);
      BAR; WAIT_L(0); MMA(0, 0, At, B0); BAR;
      LDB(B1, 0, 1); BAR; WAIT_L(0); MMA(0, 1, At, B1); BAR;
      LDA(At, 0, 1); WAIT_V(4); BAR; WAIT_L(0); MMA(1, 0, At, B0); MMA(1, 1, At, B1); BAR; }
    { LDB(B0, 1, 0); LDA(At, 1, 0); WAIT_V(2); BAR; WAIT_L(0); MMA(0, 0, At, B0); BAR;
      LDB(B1, 1, 1); WAIT_V(0); BAR; WAIT_L(0); MMA(0, 1, At, B1); BAR;
      LDA(At, 1, 1); BAR; WAIT_L(0); MMA(1, 0, At, B0); MMA(1, 1, At, B1); BAR; }
    if (wr == 0) BAR;
    epi(acc, brow, bcol, wr, wc, fr, fq);
    WAIT_V(0);
    __syncthreads();
#undef SA
#undef SB
#undef STAGE
#undef LDA
#undef LDB
#undef MMA
#undef WAIT_V
#undef WAIT_L
#undef BAR
#undef SCHED
}

template <class F>
__device__ __forceinline__ void epi_each(const f32x4 (&acc)[2][2][4][2], int brow, int bcol, int wr, int wc, int fr, int fq, F f) {
#pragma unroll
    for (int ai = 0; ai < 2; ++ai)
#pragma unroll
        for (int m = 0; m < 4; ++m)
#pragma unroll
            for (int bj = 0; bj < 2; ++bj) f(brow + ai * 128 + wr * 64 + m * 16 + fr, bcol + bj * 128 + wc * 32 + fq * 8, acc[ai][bj][m][0], acc[ai][bj][m][1]);
}
__device__ __forceinline__ void st_bf16x4(bf16_t* p, f32x4 v) { u32x2 w; w.x = cvt_pk_bf16(v[0], v[1]); w.y = cvt_pk_bf16(v[2], v[3]); *(u32x2*)p = w; }
__device__ __forceinline__ void st_bf16x8(bf16_t* p, f32x4 a, f32x4 b) { u32x4 w; w.x = cvt_pk_bf16(a[0], a[1]); w.y = cvt_pk_bf16(a[2], a[3]); w.z = cvt_pk_bf16(b[0], b[1]); w.w = cvt_pk_bf16(b[2], b[3]); *(u32x4*)p = w; }
__device__ __forceinline__ void st_bf16_T(bf16_t* base, size_t col, int row, f32x4 v) {
#pragma unroll
    for (int j = 0; j < 4; ++j) base[(col + j) * (size_t)T + row] = f2bf(v[j]);
}

struct EpiIn0 {
    bf16_t *Q0, *K0, *V0T, *Z, *XBC; float *DT, *outK, *outV;
    __device__ __forceinline__ void operator()(const f32x4 (&acc)[2][2][4][2], int brow, int bcol, int wr, int wc, int fr, int fq) const {
        if (bcol < 512) epi_each(acc, brow, bcol, wr, wc, fr, fq, [&](int r, int c, f32x4 v, f32x4 w) { st_bf16x8(Q0 + (size_t)r * 512 + c, v * 0.125f, w * 0.125f); });
        else if (bcol < 1024) epi_each(acc, brow, bcol, wr, wc, fr, fq, [&](int r, int c, f32x4 v, f32x4 w) { c -= 512; st_bf16x8(K0 + (size_t)r * 512 + c, v, w);
            if (r < TC) { *(f32x4*)(outK + (size_t)r * 512 + c) = v; *(f32x4*)(outK + (size_t)r * 512 + c + 4) = w; } });
        else if (bcol < 1536) epi_each(acc, brow, bcol, wr, wc, fr, fq, [&](int r, int c, f32x4 v, f32x4 w) { c -= 1024; st_bf16_T(V0T, c, r, v); st_bf16_T(V0T, c + 4, r, w);
            if (r < TC) { *(f32x4*)(outV + (size_t)r * 512 + c) = v; *(f32x4*)(outV + (size_t)r * 512 + c + 4) = w; } });
        else if (bcol < 2560) epi_each(acc, brow, bcol, wr, wc, fr, fq, [&](int r, int c, f32x4 v, f32x4 w) { st_bf16x8(Z + (size_t)r * 1024 + (c - 1536), v, w); });
        else epi_each(acc, brow, bcol, wr, wc, fr, fq, [&](int r, int c, f32x4 v, f32x4 w) { st_bf16x8(XBC + (size_t)r * 1536 + (c - 2560), v, w); });
    }
};
struct EpiRes {
    const float *baseA, *baseB;
    float* XA; const float* gate;
    __device__ __forceinline__ void operator()(const f32x4 (&acc)[2][2][4][2], int brow, int bcol, int wr, int wc, int fr, int fq) const {
        const float* base = brow < TC ? baseA : baseB - (size_t)TC * 1024;
        const float* g = gate + (brow < TC ? 0 : (1 + (brow - TC) / 1024) * 6144);
        const int cb = bcol + wc * 32 + fq * 8;
        const f32x4 g00 = *(const f32x4*)(g + cb), g01 = *(const f32x4*)(g + cb + 4), g10 = *(const f32x4*)(g + cb + 128), g11 = *(const f32x4*)(g + cb + 132);
        epi_each(acc, brow, bcol, wr, wc, fr, fq, [&](int r, int c, f32x4 v, f32x4 w) {
            const f32x4 b0 = *(const f32x4*)(base + (size_t)r * 1024 + c), b1 = *(const f32x4*)(base + (size_t)r * 1024 + c + 4); const bool hi = (c - cb) != 0;
            *(f32x4*)(XA + (size_t)r * 1024 + c) = b0 + (hi ? g10 : g00) * v; *(f32x4*)(XA + (size_t)r * 1024 + c + 4) = b1 + (hi ? g11 : g01) * w; });
    }
};
struct EpiSwiglu {
    bf16_t* HID;
    __device__ __forceinline__ void operator()(const f32x4 (&acc)[2][2][4][2], int brow, int bcol, int wr, int wc, int fr, int fq) const {
        const int hc0 = (bcol >> 1) + wc * 32 + fq * 8;
#pragma unroll
        for (int ai = 0; ai < 2; ++ai)
#pragma unroll
            for (int m = 0; m < 4; ++m) {
                f32x4 o[2];
#pragma unroll
                for (int n = 0; n < 2; ++n) { const f32x4 a = acc[ai][0][m][n], b = acc[ai][1][m][n];
#pragma unroll
                    for (int j = 0; j < 4; ++j) o[n][j] = siluf(a[j]) * b[j]; }
                st_bf16x8(HID + (size_t)(brow + ai * 128 + wr * 64 + m * 16 + fr) * FFN + hc0, o[0], o[1]);
            }
    }
};
__device__ __forceinline__ f32x4 rope4(f32x4 v, int r, int c) {
    const int t = (r - TC) & 1023, grow = t >> 6, gcol = t & 63, d = c & 255, p0 = d >> 1;
    f32x4 o;
#pragma unroll
    for (int q = 0; q < 2; ++q) {
        const int p = p0 + q; const float pos = (float)(p < 64 ? grow : gcol);
        const float fr_ = exp2f(-(float)(p & 63) * (13.287712379549449f / 64.f));
        const float ang = pos * fr_; const float cs = __cosf(ang), sn = __sinf(ang);
        const float x1 = v[2 * q], x2 = v[2 * q + 1];
        o[2 * q] = x1 * cs - x2 * sn; o[2 * q + 1] = x1 * sn + x2 * cs;
    }
    return o;
}
struct EpiIn1 {
    bf16_t *QR, *KR, *KRT, *VRT, *GR;
    __device__ __forceinline__ void operator()(const f32x4 (&acc)[2][2][4][2], int brow, int bcol, int wr, int wc, int fr, int fq) const {
        const bool lat = brow >= TC;
        if (bcol < 1024) epi_each(acc, brow, bcol, wr, wc, fr, fq, [&](int r, int c, f32x4 v, f32x4 w) { if (lat) { v = rope4(v, r, c); w = rope4(w, r, c + 4); } st_bf16x8(QR + (size_t)r * 1024 + c, v, w); });
        else if (bcol < 2048) epi_each(acc, brow, bcol, wr, wc, fr, fq, [&](int r, int c, f32x4 v, f32x4 w) { c -= 1024; v = v * 0.0625f; w = w * 0.0625f; if (lat) { v = rope4(v, r, c); w = rope4(w, r, c + 4); }
            st_bf16x8(KR + (size_t)r * 1024 + c, v, w); st_bf16_T(KRT, c, r, v); st_bf16_T(KRT, c + 4, r, w); });
        else if (bcol < 4096) epi_each(acc, brow, bcol, wr, wc, fr, fq, [&](int r, int c, f32x4 v, f32x4 w) { st_bf16_T(VRT, c - 2048, r, v); st_bf16_T(VRT, c - 2048 + 4, r, w); });
        else epi_each(acc, brow, bcol, wr, wc, fr, fq, [&](int r, int c, f32x4 v, f32x4 w) { st_bf16x8(GR + (size_t)r * 2048 + (c - 4096), v, w); });
    }
};

__device__ __forceinline__ void prep_phase(const Params& p, LAS unsigned char* lds, const int part, const int bx, const int G);
template <class Epi>
__device__ __forceinline__ void gemm_phase(LAS unsigned char* lds, const bf16_t* A, const bf16_t* Bt, int N, int K, const Epi& epi, const Params* pp = nullptr, int idle_part = 0) {
    const int nM = T / BM, nN = N / BM;
    if (idle_part && (int)blockIdx.x >= nM * nN) { prep_phase(*pp, lds, idle_part, (int)blockIdx.x - nM * nN, (int)gridDim.x - nM * nN); return; }
    for (int i = 0;; ++i) { int pm, pn; if (!tile_of(i * (int)gridDim.x + (int)blockIdx.x, nM, nN, pm, pn)) break; gemm_tile(lds, A, Bt, K, pm * BM, pn * BM, epi); }
}

__device__ __forceinline__ void transpose_tile(LAS unsigned char* lds, const float* __restrict__ src, int N, int k0, int n0, bf16_t* __restrict__ dst, int drow0, int ldd) {
    LAS float* tl = (LAS float*)lds; const int tid = threadIdx.x;
#pragma unroll
    for (int i = 0; i < 2; ++i) { const int r = (tid >> 4) + 32 * i, c = (tid & 15) * 4;
        f32x4 v = (f32x4){0.f, 0.f, 0.f, 0.f}; if (n0 + c < N) v = *(const f32x4*)(src + (size_t)(k0 + r) * N + n0 + c);
        tl[r * 65 + c] = v[0]; tl[r * 65 + c + 1] = v[1]; tl[r * 65 + c + 2] = v[2]; tl[r * 65 + c + 3] = v[3]; }
    __syncthreads();
    { const int n = tid >> 3, kg = (tid & 7) * 8; float x[8];
#pragma unroll
      for (int e = 0; e < 8; ++e) x[e] = tl[(kg + e) * 65 + n];
      u32x4 w; w.x = cvt_pk_bf16(x[0], x[1]); w.y = cvt_pk_bf16(x[2], x[3]); w.z = cvt_pk_bf16(x[4], x[5]); w.w = cvt_pk_bf16(x[6], x[7]);
      *(u32x4*)(dst + (size_t)(drow0 + n) * ldd + k0 + kg) = w; }
    __syncthreads();
}
struct TJob { const float* src; bf16_t* dst; int K, N, Npad, mode; };
__device__ __forceinline__ void prep_phase(const Params& p, LAS unsigned char* lds, const int part, const int bx, const int G) {
    unsigned char* ws = p.ws; const int tid = threadIdx.x;
    const int mod_lo = part == 0 ? 0 : 96, mod_hi = part == 0 ? 96 : (part == 1 ? 192 : 96), job_lo = part == 0 ? 0 : 5, job_hi = part == 0 ? 5 : (part == 2 ? 10 : 5);
    float* MOD = (float*)(ws + O_MOD);
    if (mod_lo + bx < mod_hi) {
        LAS float* sc = (LAS float*)lds;
        LAS float* part = sc + 5 * 1024;
        for (int u = tid; u < 5 * 1024; u += NTHR) { const int ci = u >> 10, k = u & 1023; const float c = ci == 0 ? p.in[7][k] : p.in[6][(ci - 1) * 1024 + k]; sc[u] = siluf(c); }
        __syncthreads();
        for (int it = mod_lo + bx; it < mod_hi; it += G) {
            const int l = it / 96, n0 = (it % 96) * 64; const float* W = p.in[l == 0 ? 10 : 26]; const float* Bv = p.in[l == 0 ? 11 : 27];
            const int w = tid >> 6, lane = tid & 63, cg4 = (lane & 15) * 4, kq = lane >> 4; f32x4 a[5];
#pragma unroll
            for (int ci = 0; ci < 5; ++ci) a[ci] = (f32x4){0.f, 0.f, 0.f, 0.f};
#pragma unroll 8
            for (int i = 0; i < 32; ++i) { const int k = w * 128 + i * 4 + kq; const f32x4 wv = *(const f32x4*)(W + (size_t)k * 6144 + n0 + cg4);
#pragma unroll
                for (int ci = 0; ci < 5; ++ci) a[ci] += wv * sc[ci * 1024 + k]; }
#pragma unroll
            for (int ci = 0; ci < 5; ++ci) {
#pragma unroll
                for (int j = 0; j < 4; ++j) { float v = a[ci][j]; v += __shfl_xor(v, 16); v += __shfl_xor(v, 32); a[ci][j] = v; }
                if (kq == 0) *(LAS f32x4*)(part + (w * 5 + ci) * 64 + cg4) = a[ci]; }
            __syncthreads();
            if (tid < 320) { const int ci = tid >> 6, ln = tid & 63; float s = 0.f;
#pragma unroll
                for (int w2 = 0; w2 < 8; ++w2) s += part[(w2 * 5 + ci) * 64 + ln];
                MOD[(size_t)(l * 5 + ci) * 6144 + n0 + ln] = s + Bv[n0 + ln]; }
            __syncthreads();
        }
    }
    if (part == 0) { bf16_t* CK = (bf16_t*)(ws + O_CK); const float* src = p.in[2];
      for (int u = bx * NTHR + tid; u < 4 * 256 * 512 / 4; u += G * NTHR) { const f32x4 v = *(const f32x4*)(src + (size_t)u * 4); st_bf16x4(CK + (size_t)u * 4, v); } }
    for (int j = job_lo; j < (part == 0 ? 14 : job_hi); ++j) {
        if (part == 0 && j >= 5 && j < 10) continue;
        TJob jb;
        switch (j) {
            case 0: jb = {p.in[12], (bf16_t*)(ws + O_W0IN), 1024, 4128, 4352, 0}; break;
            case 1: jb = {p.in[13], (bf16_t*)(ws + O_W0OUT), 1536, 1024, 1024, 0}; break;
            case 2: jb = {p.in[21], (bf16_t*)(ws + O_W0UP), 1024, 2816, 2816, 1}; break;
            case 3: jb = {p.in[22], (bf16_t*)(ws + O_W0UP), 1024, 2816, 2816, 2}; break;
            case 4: jb = {p.in[23], (bf16_t*)(ws + O_W0DN), 2816, 1024, 1024, 0}; break;
            case 5: jb = {p.in[28], (bf16_t*)(ws + O_W1IN), 1024, 6144, 6144, 0}; break;
            case 6: jb = {p.in[29], (bf16_t*)(ws + O_W1OUT), 2048, 1024, 1024, 0}; break;
            case 7: jb = {p.in[32], (bf16_t*)(ws + O_W1UP), 1024, 2816, 2816, 1}; break;
            case 8: jb = {p.in[33], (bf16_t*)(ws + O_W1UP), 1024, 2816, 2816, 2}; break;
            case 9: jb = {p.in[34], (bf16_t*)(ws + O_W1DN), 2816, 1024, 1024, 0}; break;
            default: jb = {p.in[3] + (size_t)(j - 10) * 256 * 512, (bf16_t*)(ws + O_CVT) + (size_t)(j - 10) * 512 * 256, 256, 512, 512, 0}; break;
        }
        const int nkt = jb.K / 64, nnt = jb.Npad / 64, ntile = nkt * nnt;
        for (int tix = (bx + 64 * j) % G; tix < ntile; tix += G) {
            const int kt = tix % nkt, ntl = tix / nkt, n0 = ntl * 64;
            int drow0 = n0; if (jb.mode) drow0 = (n0 / 128) * 256 + (n0 % 128) + (jb.mode == 2 ? 128 : 0);
            transpose_tile(lds, jb.src, jb.N, kt * 64, n0, jb.dst, drow0, jb.K);
        }
    }
}

__device__ __forceinline__ void norm_phase(const float* xa, const float* xb, const float* nw, const float* mod  , int sh_off, int sc_off, bf16_t* H, float* outf) {
    const int lane = threadIdx.x & 63, gw = blockIdx.x * 8 + (threadIdx.x >> 6), nw_tot = gridDim.x * 8;
    for (int r0 = gw; r0 < T; r0 += 2 * nw_tot) {
        const int r1 = r0 + nw_tot < T ? r0 + nw_tot : r0;
        f32x4 v[2][4]; float ss[2];
#pragma unroll
        for (int u = 0; u < 2; ++u) { const int r = u ? r1 : r0; const float* x = r < TC ? xa + (size_t)r * 1024 : xb + (size_t)(r - TC) * 1024; ss[u] = 0.f;
#pragma unroll
            for (int q = 0; q < 4; ++q) { v[u][q] = *(const f32x4*)(x + (q >> 1) * 512 + lane * 8 + (q & 1) * 4); ss[u] += v[u][q][0] * v[u][q][0] + v[u][q][1] * v[u][q][1] + v[u][q][2] * v[u][q][2] + v[u][q][3] * v[u][q][3]; } }
#pragma unroll
        for (int u = 0; u < 2; ++u) {
            const int r = u ? r1 : r0; if (u && r1 == r0) break;
            const float rstd = rsqrtf(wave_sum(ss[u]) * (1.f / 1024.f) + 1e-6f);
            if (outf) {
#pragma unroll
                for (int q = 0; q < 4; ++q) { const int c = (q >> 1) * 512 + lane * 8 + (q & 1) * 4; const f32x4 w = *(const f32x4*)(nw + c); *(f32x4*)(outf + (size_t)r * 1024 + c) = v[u][q] * rstd * w; }
            } else {
                const float* md = mod + (r < TC ? 0 : (1 + (r - TC) / 1024) * 6144);
#pragma unroll
                for (int h2 = 0; h2 < 2; ++h2) { const int c = h2 * 512 + lane * 8; f32x4 o[2];
#pragma unroll
                    for (int e = 0; e < 2; ++e) { const f32x4 w = *(const f32x4*)(nw + c + 4 * e), sc = *(const f32x4*)(md + sc_off + c + 4 * e), sh = *(const f32x4*)(md + sh_off + c + 4 * e);
                        o[e] = v[u][h2 * 2 + e] * rstd * w * (sc + 1.f) + sh; }
                    st_bf16x8(H + (size_t)r * 1024 + c, o[0], o[1]); }
            }
        }
    }
}

__device__ __forceinline__ void conv_phase(const Params& p, LAS unsigned char* lds) {
    unsigned char* ws = p.ws; const bf16_t* XBC = (const bf16_t*)(ws + O_XBC); bf16_t* XC = (bf16_t*)(ws + O_XC); bf16_t* XT = (bf16_t*)(ws + O_XT);
    const float* cw = p.in[15]; const float* cb = p.in[16];
    const int tid = threadIdx.x; LAS bf16_t* tl = (LAS bf16_t*)lds;
    for (int it = blockIdx.x; it < 96 * 24; it += gridDim.x) {
        const int tt = it / 24, ct = it % 24, tok0 = tt * 128, c0 = ct * 64;
        const int L = tok0 < TC ? 256 : 1024, ts0 = tok0 < TC ? (tok0 & 255) : ((tok0 - TC) & 1023);
        const int tp = (tid >> 3) * 2, cg_ = (tid & 7) * 8, tok = tok0 + tp, ts = ts0 + tp, ch = c0 + cg_;
        u32x4 rw[6];
#pragma unroll
        for (int k = 0; k < 6; ++k) { const int tsk = ts + k - 2; rw[k] = (u32x4){0u, 0u, 0u, 0u}; if (tsk >= 0 && tsk < L) rw[k] = *(const u32x4*)(XBC + (size_t)(tok + k - 2) * 1536 + ch); }
        float a0[8], a1[8];
        { const f32x4 b0 = *(const f32x4*)(cb + ch), b1 = *(const f32x4*)(cb + ch + 4);
#pragma unroll
          for (int e = 0; e < 4; ++e) { a0[e] = b0[e]; a0[e + 4] = b1[e]; a1[e] = b0[e]; a1[e + 4] = b1[e]; } }
#pragma unroll
        for (int k = 0; k < 5; ++k) { const f32x4 w0 = *(const f32x4*)(cw + k * 1536 + ch), w1 = *(const f32x4*)(cw + k * 1536 + ch + 4);
            float x0[8], x1[8]; unpack8(rw[k], x0); unpack8(rw[k + 1], x1);
#pragma unroll
            for (int e = 0; e < 8; ++e) { const float wv = e < 4 ? w0[e] : w1[e - 4]; a0[e] += wv * x0[e]; a1[e] += wv * x1[e]; } }
#pragma unroll
        for (int e = 0; e < 8; ++e) { a0[e] = siluf(a0[e]); a1[e] = siluf(a1[e]); }
        u32x4 o0, o1; o0.x = cvt_pk_bf16(a0[0], a0[1]); o0.y = cvt_pk_bf16(a0[2], a0[3]); o0.z = cvt_pk_bf16(a0[4], a0[5]); o0.w = cvt_pk_bf16(a0[6], a0[7]);
        o1.x = cvt_pk_bf16(a1[0], a1[1]); o1.y = cvt_pk_bf16(a1[2], a1[3]); o1.z = cvt_pk_bf16(a1[4], a1[5]); o1.w = cvt_pk_bf16(a1[6], a1[7]);
        *(u32x4*)(XC + (size_t)tok * 1536 + ch) = o0; *(u32x4*)(XC + (size_t)(tok + 1) * 1536 + ch) = o1;
        if (ct < 20) {
#pragma unroll
            for (int e = 0; e < 8; ++e) *(LAS unsigned*)(tl + (cg_ + e) * 136 + tp) = cvt_pk_bf16(a0[e], a1[e]);
            __syncthreads();
#pragma unroll
            for (int q = 0; q < 2; ++q) { const int pid = q * NTHR + tid, chl = pid >> 4, tg = (pid & 15) * 8;
                const u32x4 w = *(const LAS u32x4*)(tl + chl * 136 + tg);
                *(u32x4*)(XT + (size_t)(c0 + chl) * T + tok0 + tg) = w; }
            __syncthreads();
        }
    }
}

struct NaState { float m, l; f32x4 o[4]; };
struct NaChunk { const bf16_t* kb; const bf16_t* vtb; size_t ldv; const LAS float* biasrow; int kc0; bool local; int tile;   };
__device__ __forceinline__ void na_load(const NaChunk& ch, int fr, int fq, bf16x8 (&kf)[2][2], u32x4 (&vw)[4]) {
#pragma unroll
    for (int t = 0; t < 2; ++t)
#pragma unroll
        for (int ks = 0; ks < 2; ++ks) kf[t][ks] = *(const bf16x8*)(ch.kb + (size_t)(16 * t + fr) * 512 + ks * 32 + fq * 8);
#pragma unroll
    for (int dt = 0; dt < 4; ++dt) { const bf16_t* vp = ch.vtb + (size_t)(dt * 16 + fr) * ch.ldv + 4 * fq;
        const u32x2 lo = *(const u32x2*)vp, hi = *(const u32x2*)(vp + 16); vw[dt].x = lo.x; vw[dt].y = lo.y; vw[dt].z = hi.x; vw[dt].w = hi.y; }
}
__device__ __forceinline__ void na_compute(NaState& st, const bf16x8 (&qf)[2], const bf16x8 (&kf)[2][2], const u32x4 (&vw)[4], const NaChunk& ch, int fq, int qc) {
    f32x4 s[2];
#pragma unroll
    for (int t = 0; t < 2; ++t) { s[t] = (f32x4){0.f, 0.f, 0.f, 0.f};
#pragma unroll
        for (int ks = 0; ks < 2; ++ks) s[t] = mfma16(kf[t][ks], qf[ks], s[t]); }
    if (ch.local) {
        const int c0 = min(max(qc - 8, 0), 48);
#pragma unroll
        for (int t = 0; t < 2; ++t)
#pragma unroll
            for (int j = 0; j < 4; ++j) { const int kc = ch.kc0 + 16 * t + 4 * fq + j; const bool ok = kc >= c0 && kc < c0 + 16; const int dc = min(max(kc - qc + 15, 0), 30);
                s[t][j] = ok ? s[t][j] + ch.biasrow[dc] : -INFINITY; }
    }
    float mx = fmaxf(fmaxf(fmaxf(s[0][0], s[0][1]), fmaxf(s[0][2], s[0][3])), fmaxf(fmaxf(s[1][0], s[1][1]), fmaxf(s[1][2], s[1][3])));
    mx = fmaxf(mx, __shfl_xor(mx, 16)); mx = fmaxf(mx, __shfl_xor(mx, 32));
    const float mn = fmaxf(st.m, mx), alpha = __expf(st.m - mn); st.m = mn;
    float ps = 0.f;
#pragma unroll
    for (int t = 0; t < 2; ++t)
#pragma unroll
        for (int j = 0; j < 4; ++j) { s[t][j] = __expf(s[t][j] - mn); ps += s[t][j]; }
    st.l = st.l * alpha + ps;
    u32x4 pw; pw.x = cvt_pk_bf16(s[0][0], s[0][1]); pw.y = cvt_pk_bf16(s[0][2], s[0][3]); pw.z = cvt_pk_bf16(s[1][0], s[1][1]); pw.w = cvt_pk_bf16(s[1][2], s[1][3]);
    const bf16x8 pf = as_bf16x8(pw);
#pragma unroll
    for (int dt = 0; dt < 4; ++dt) st.o[dt] = mfma16(as_bf16x8(vw[dt]), pf, st.o[dt] * alpha);
}
__device__ __forceinline__ void na_phase(const Params& p, LAS unsigned char* lds) {
    unsigned char* ws = p.ws; const bf16_t* Q0 = (const bf16_t*)(ws + O_Q0); const bf16_t* K0 = (const bf16_t*)(ws + O_K0); const bf16_t* V0T = (const bf16_t*)(ws + O_V0T);
    const bf16_t* CK = (const bf16_t*)(ws + O_CK); const bf16_t* CVT = (const bf16_t*)(ws + O_CVT); bf16_t* MIX = (bf16_t*)(ws + O_MIX); const float* nb = p.in[14];
    const int lane = threadIdx.x & 63, fr = lane & 15, fq = lane >> 4, gw = blockIdx.x * 8 + (threadIdx.x >> 6), nwv = gridDim.x * 8;
    LAS float* lnb = (LAS float*)(lds + 20480);
    for (int u = threadIdx.x; u < 8 * 465; u += NTHR) lnb[u] = nb[u];
    __syncthreads();
    { const bf16_t* H = (const bf16_t*)(ws + O_H); const bf16_t* W = (const bf16_t*)(ws + O_W0IN) + (size_t)4096 * 1024; float* DT = (float*)(ws + O_DT);
      for (int it = gw - 1024; it >= 0 && it < T / 16; it += nwv) {
          f32x4 d0 = (f32x4){0.f, 0.f, 0.f, 0.f}, d1 = d0;
#pragma unroll 8
          for (int ks = 0; ks < 32; ++ks) { const bf16x8 hf = *(const bf16x8*)(H + (size_t)(it * 16 + fr) * 1024 + ks * 32 + fq * 8);
              const bf16x8 w0 = *(const bf16x8*)(W + (size_t)fr * 1024 + ks * 32 + fq * 8), w1 = *(const bf16x8*)(W + (size_t)(16 + fr) * 1024 + ks * 32 + fq * 8);
              d0 = mfma16(w0, hf, d0); d1 = mfma16(w1, hf, d1); }
          *(f32x4*)(DT + (size_t)(it * 16 + fr) * 32 + 4 * fq) = d0; *(f32x4*)(DT + (size_t)(it * 16 + fr) * 32 + 16 + 4 * fq) = d1; } }
    const int bx = blockIdx.x, wv = threadIdx.x >> 6;
    for (int k = 0; k < 2; ++k) {
        int it;
        if (gridDim.x != 256) { it = gw * 2 + k; if (gw * 2 + k >= 3072) break; if (gw >= 512 && k == 0) { } it = (gw < 1024) ? (k ? -1 : gw) : 1024 + 2 * (gw - 1024) + k; if (it < 0) break; }
        else if (bx < 128) { if (k) break; const int q = (bx >> 3) * 8 + wv; it = ((q >> 5) << 8) | ((bx & 7) << 5) | (q & 31); }
        else { const int j = bx - 128, x = j & 7, idx = (j >> 3) * 16 + wv * 2 + k; it = 1024 + (((4 * x + (idx >> 6)) << 6) | (idx & 63)); }
        if (it >= 1024 + 2048) break;
        NaState st[2];
#pragma unroll
        for (int u = 0; u < 2; ++u) { st[u].m = -INFINITY; st[u].l = 0.f;
#pragma unroll
            for (int d = 0; d < 4; ++d) st[u].o[d] = (f32x4){0.f, 0.f, 0.f, 0.f}; }
        bf16x8 qf[2][2]; int qtok0, h, b, r = 0, qc0 = 0, NC = 8; const bool lat = it < 1024;
        if (lat) { b = it >> 8; h = (it >> 5) & 7; r = (it >> 1) & 15; qc0 = (it & 1) * 32; qtok0 = TC + b * 1024 + r * 64 + qc0 + fr; NC = 24; }
        else { const int u = it - 1024; b = u >> 6; h = (u >> 3) & 7; qtok0 = b * 256 + (u & 7) * 32 + fr; }
        const int r0 = min(max(r - 4, 0), 8);
#pragma unroll
        for (int u = 0; u < 2; ++u)
#pragma unroll
            for (int ks = 0; ks < 2; ++ks) qf[u][ks] = *(const bf16x8*)(Q0 + (size_t)(qtok0 + 16 * u) * 512 + h * 64 + ks * 32 + fq * 8);
        auto get = [&](int c) { NaChunk ch; ch.biasrow = lnb; ch.kc0 = 0; ch.local = false; ch.tile = -1;
            if (!lat) { const int ktok = b * 256 + c * 32; ch.kb = K0 + (size_t)ktok * 512 + h * 64; ch.vtb = V0T + (size_t)(h * 64) * T + ktok; ch.ldv = T; }
            else if (c < 8) { ch.kb = CK + (size_t)(b * 256 + c * 32) * 512 + h * 64; ch.vtb = CVT + (size_t)(b * 512 + h * 64) * 256 + c * 32; ch.ldv = 256; }
            else {
                const int l = c - 8, s_ = l >> 1, u = l & 1, br = r0 + s_, ct = qc0 + 16 * u, kc0 = min(min(max(ct - 8, 0), 48), 32), ktok = TC + b * 1024 + br * 64 + kc0;
                ch.kb = K0 + (size_t)ktok * 512 + h * 64; ch.vtb = V0T + (size_t)(h * 64) * T + ktok; ch.ldv = T; ch.biasrow = lnb + h * 465 + (br - r + 7) * 31; ch.kc0 = kc0; ch.local = true; ch.tile = u; }
            return ch; };
        bf16x8 kfa[2][2], kfb[2][2], kfc[2][2]; u32x4 vwa[4], vwb[4], vwc[4];
        { const NaChunk c0_ = get(0), c1_ = get(1); na_load(c0_, fr, fq, kfa, vwa); na_load(c1_, fr, fq, kfb, vwb); }
        auto step = [&](const bf16x8 (&kfx)[2][2], const u32x4 (&vwx)[4], bf16x8 (&kfy)[2][2], u32x4 (&vwy)[4], int c) {
            if (c + 2 < NC) { const NaChunk n2 = get(c + 2); na_load(n2, fr, fq, kfy, vwy); }
            const NaChunk cur = get(c);
            if (cur.tile != 1) na_compute(st[0], qf[0], kfx, vwx, cur, fq, qc0 + fr);
            if (cur.tile != 0) na_compute(st[1], qf[1], kfx, vwx, cur, fq, qc0 + 16 + fr);
        };
        for (int c = 0; c < NC; c += 3) {
            step(kfa, vwa, kfc, vwc, c);
            if (c + 1 < NC) step(kfb, vwb, kfa, vwa, c + 1);
            if (c + 2 < NC) step(kfc, vwc, kfb, vwb, c + 2);
        }
#pragma unroll
        for (int u = 0; u < 2; ++u) { float l = st[u].l; l += __shfl_xor(l, 16); l += __shfl_xor(l, 32); const float inv = 1.f / l;
#pragma unroll
            for (int dt = 0; dt < 4; ++dt) st_bf16x4(MIX + (size_t)(qtok0 + 16 * u) * 1536 + h * 64 + dt * 16 + 4 * fq, st[u].o[dt] * inv); }
    }
}

__device__ __forceinline__ LAS unsigned char* opq(LAS unsigned char* p) { asm volatile("" : "+v"(p)); return p; }
template <int DK, bool SSD, int DV, bool GPRE>
__device__ __forceinline__ void scan_item(LAS unsigned char* lds, const bf16_t* Qg, const bf16_t* Kg, int ldqk, const bf16_t* KTg, const bf16_t* VTg, int tok0, int nch, int dir,
                          const float* s0, float* sfin, int ldS, bf16_t* Y, int ldy, const float* DTp, float dtb, float aneg, const float* GPh  ) {
    constexpr int NKS = DK / 32, RS = DK * 2 + 16, TS = 144, NPT = DV / 16, NPW = NPT / 2  , NPI = NPT / 4  ;
    constexpr int OQ = 1024, OK_ = OQ + 64 * RS, OKT = GPRE ? OK_ : OK_ + 64 * RS, OVT = OKT + DK * TS, OS = OVT + DV * TS;
    static_assert(OS + DV * RS <= LDS_XB_OFF, "scan LDS budget");
    constexpr int NPQ = 64 * DK / 8 / NTHR, NPKT = DK * 8 / NTHR, NPV = DV * 8 / NTHR, C8 = DK / 8, NPK = GPRE ? 0 : NPQ;
    constexpr int TAB_OFF = SSD ? OS + DV * RS : 0, TAB_F = 208;
    static_assert(!SSD || TAB_OFF + 16 * TAB_F * 4 <= LDS_XB_OFF, "scan table budget");
    const int tid = threadIdx.x, wid = __builtin_amdgcn_readfirstlane(tid >> 6), lane = tid & 63, fr = lane & 15, fq = lane >> 4;
    const int it = wid & 3, ph = wid >> 2, i = it * 16 + fr;
    constexpr int RPQ = NTHR / C8;
    LAS unsigned char* const qb = opq(lds + OQ + i * RS + fq * 16);
    LAS unsigned char* const kb_ = opq(lds + OK_ + fr * RS + fq * 16);
    LAS unsigned char* const zb = opq(lds + OS + (NPW * ph * 16 + fr) * RS + fq * 16);
    LAS unsigned char* const ktb = opq(lds + OKT + (ph * NKS * 16 + fr) * TS + fq * 16);
    LAS unsigned char* const vyb = opq(lds + OVT + (NPW * ph * 16 + fr) * TS + fq * 8);
    LAS unsigned char* const vsb = opq(lds + OVT + (it * 16 + fr) * TS + fq * 16);
    LAS unsigned char* const stb = opq(lds + OS + (it * 16 + 4 * fq) * RS + (ph * NKS * 16 + fr) * 2);
    LAS unsigned char* const cqb = opq(lds + OQ + (tid / C8) * RS + (tid % C8) * 16);
    LAS unsigned char* const ckb = opq(lds + OK_ + (tid / C8) * RS + (tid % C8) * 16);
    LAS unsigned char* const cktb = opq(lds + OKT + (tid >> 3) * TS + (tid & 7) * 16);
    LAS unsigned char* const cvb = opq(lds + OVT + (tid >> 3) * TS + (tid & 7) * 16);
    u32x4 pf[NPQ + NPK + NPKT + NPV]; f32x4 gcur[4];
    auto issue = [&](int tokc) {
        int t_ = tid; asm volatile("" : "+v"(t_));
#pragma unroll
        for (int q = 0; q < NPQ; ++q) { const int pid = q * NTHR + t_, row = pid / C8, c8 = pid % C8;
            pf[q] = *(const u32x4*)(Qg + (size_t)(tokc + row) * ldqk + c8 * 8); if (!GPRE) pf[NPQ + q] = *(const u32x4*)(Kg + (size_t)(tokc + row) * ldqk + c8 * 8); }
#pragma unroll
        for (int q = 0; q < NPKT; ++q) { const int pid = q * NTHR + t_, n = pid >> 3, tg = pid & 7; pf[NPQ + NPK + q] = *(const u32x4*)(KTg + (size_t)n * T + tokc + tg * 8); }
#pragma unroll
        for (int q = 0; q < NPV; ++q) { const int pid = q * NTHR + t_, pr = pid >> 3, tg = pid & 7; pf[NPQ + NPK + NPKT + q] = *(const u32x4*)(VTg + (size_t)pr * T + tokc + tg * 8); }
    };
    auto issue_g = [&](int tokc) {
#pragma unroll
        for (int jt = 0; jt < 4; ++jt) if (dir ? (jt >= it) : (jt <= it)) gcur[jt] = *(const f32x4*)(GPh + ((size_t)((tokc >> 6) * 4 * 16 + it * 4 + jt) * 64 + lane) * 4);
    };
    auto commit = [&]() {
#pragma unroll
        for (int q = 0; q < NPQ; ++q) { *(LAS u32x4*)(cqb + q * RPQ * RS) = pf[q]; if (!GPRE) *(LAS u32x4*)(ckb + q * RPQ * RS) = pf[NPQ + q]; }
#pragma unroll
        for (int q = 0; q < NPKT; ++q) *(LAS u32x4*)(cktb + q * 64 * TS) = pf[NPQ + NPK + q];
#pragma unroll
        for (int q = 0; q < NPV; ++q) *(LAS u32x4*)(cvb + q * 64 * TS) = pf[NPQ + NPK + NPKT + q];
    };
    const bool oddl = fr & 1;
    LAS unsigned char* const stb2 = opq(stb + (oddl ? 2 * RS - 2 : 0));
    auto put_state = [&](const f32x4 (&sacc)[NPI][NKS]) {
#pragma unroll
        for (int pi = 0; pi < NPI; ++pi)
#pragma unroll
            for (int q = 0; q < NKS; ++q) { const f32x4 a = sacc[pi][q];
                const float s0_ = oddl ? a[0] : a[2], s1_ = oddl ? a[1] : a[3];
                const float r0_ = __int_as_float(__builtin_amdgcn_update_dpp(0, __float_as_int(s0_), 0xB1, 0xF, 0xF, true));
                const float r1_ = __int_as_float(__builtin_amdgcn_update_dpp(0, __float_as_int(s1_), 0xB1, 0xF, 0xF, true));
                const unsigned w0 = oddl ? cvt_pk_bf16(r0_, a[2]) : cvt_pk_bf16(a[0], r0_), w1 = oddl ? cvt_pk_bf16(r1_, a[3]) : cvt_pk_bf16(a[1], r1_);
                *(LAS unsigned*)(stb2 + (pi * 64) * RS + q * 32) = w0; *(LAS unsigned*)(stb2 + (pi * 64 + 1) * RS + q * 32) = w1; }
    };
    issue(tok0 + (dir ? nch - 1 : 0) * 64);
    for (int c = wid; c < (SSD ? nch : 1); c += 8) {
        float dt = 1.f, a = aneg;
        if (SSD) { dt = softplusf(DTp[(size_t)(tok0 + c * 64 + lane) * 32] + dtb); a = dt * aneg; }
        float cs = a;
#pragma unroll
        for (int o = 1; o < 64; o <<= 1) { const float v = __shfl_up(cs, o); if (lane >= o) cs += v; }
        const float tot = __shfl(cs, 63), e = dir ? (tot - cs + a) : cs;
        LAS float* tb = (LAS float*)(lds + TAB_OFF) + c * TAB_F;
        tb[lane] = e; tb[64 + lane] = dt; tb[128 + lane] = dt * __expf(tot - e); if (lane == 0) tb[192] = tot;
    }
    f32x4 sacc[NPI][NKS];
#pragma unroll
    for (int pi = 0; pi < NPI; ++pi)
#pragma unroll
        for (int q = 0; q < NKS; ++q) { const int nt = ph * NKS + q, ptl = it + 4 * pi;
            sacc[pi][q] = s0 ? *(const f32x4*)(s0 + (size_t)(nt * 16 + fr) * ldS + ptl * 16 + 4 * fq) : (f32x4){0.f, 0.f, 0.f, 0.f}; }
    put_state(sacc);
#pragma unroll
    for (int jt = 0; jt < 4; ++jt) gcur[jt] = (f32x4){0.f, 0.f, 0.f, 0.f};
    if (GPRE) issue_g(tok0 + (dir ? nch - 1 : 0) * 64);
    commit();
    for (int cc = 0; cc < nch; ++cc) {
        const int c = dir ? nch - 1 - cc : cc, tokc = tok0 + c * 64;
        const bool has_next = cc + 1 < nch; const int tokn = tok0 + (dir ? c - 1 : c + 1) * 64;
        if (!GPRE && has_next) issue(tokn);
        LAS float* const le = (LAS float*)(lds + TAB_OFF) + (SSD ? c : 0) * TAB_F; LAS float* const ldtv = le + 64; LAS float* const ldtt = le + 128; LAS float* const lE = le + 192;
        __syncthreads();
        const float ei = le[i];
        bf16x8 qf[NKS];
        if (!GPRE) {
#pragma unroll
            for (int ks = 0; ks < NKS; ++ks) qf[ks] = *(const LAS bf16x8*)(qb + ks * 64);
        }
        unsigned pw[2][4];
#pragma unroll
        for (int jt = 0; jt < 4; ++jt) {
            const bool tv = dir ? (jt >= it) : (jt <= it);
            f32x4 g = (f32x4){0.f, 0.f, 0.f, 0.f};
            if (tv) {
                if (GPRE) g = gcur[jt];
                else {
#pragma unroll
                    for (int ks = 0; ks < NKS; ++ks) { const bf16x8 kf = *(const LAS bf16x8*)(kb_ + jt * 16 * RS + ks * 64); g = mfma16(kf, qf[ks], g); }
                }
                const f32x4 ej = *(const LAS f32x4*)(le + jt * 16 + 4 * fq);
#pragma unroll
                for (int j = 0; j < 4; ++j) { const int jj = jt * 16 + 4 * fq + j; const bool ok = dir ? (jj >= i) : (jj <= i); g[j] = ok ? g[j] * __expf(ei - ej[j]) : 0.f; }
            }
            pw[jt >> 1][(jt & 1) * 2] = cvt_pk_bf16(g[0], g[1]); pw[jt >> 1][(jt & 1) * 2 + 1] = cvt_pk_bf16(g[2], g[3]);
        }
        if (GPRE && has_next) { issue_g(tokn); issue(tokn); }
        const float ex = __expf(ei);
        f32x4 ya[NPW], za[NPW];
#pragma unroll
        for (int pp = 0; pp < NPW; ++pp) {
            const int pt = NPW * ph + pp; ya[pp] = (f32x4){0.f, 0.f, 0.f, 0.f}; za[pp] = (f32x4){0.f, 0.f, 0.f, 0.f};
#pragma unroll
            for (int k2 = 0; k2 < 2; ++k2) {
                const bool skip = dir ? (2 * k2 + 1 < it) : (2 * k2 > it);
                if (!skip) {
                    const LAS unsigned char* vp = vyb + pp * 16 * TS + k2 * 64;
                    u32x2 lo = *(const LAS u32x2*)vp, hi = *(const LAS u32x2*)(vp + 32);
                    if (SSD) { const int j0 = 32 * k2 + 4 * fq; const f32x4 d0 = *(const LAS f32x4*)(ldtv + j0), d1 = *(const LAS f32x4*)(ldtv + j0 + 16);
                        lo.x = cvt_pk_bf16(bf_lo(lo.x) * d0[0], bf_hi(lo.x) * d0[1]); lo.y = cvt_pk_bf16(bf_lo(lo.y) * d0[2], bf_hi(lo.y) * d0[3]);
                        hi.x = cvt_pk_bf16(bf_lo(hi.x) * d1[0], bf_hi(hi.x) * d1[1]); hi.y = cvt_pk_bf16(bf_lo(hi.y) * d1[2], bf_hi(hi.y) * d1[3]); }
                    u32x4 vw; vw.x = lo.x; vw.y = lo.y; vw.z = hi.x; vw.w = hi.y;
                    u32x4 pfr; pfr.x = pw[k2][0]; pfr.y = pw[k2][1]; pfr.z = pw[k2][2]; pfr.w = pw[k2][3];
                    ya[pp] = mfma16(as_bf16x8(vw), as_bf16x8(pfr), ya[pp]);
                }
            }
        }
#pragma unroll
        for (int ks = 0; ks < NKS; ++ks) {
            const bf16x8 qk = GPRE ? *(const LAS bf16x8*)(qb + ks * 64) : qf[ks];
#pragma unroll
            for (int pp = 0; pp < NPW; ++pp) { const bf16x8 sf = *(const LAS bf16x8*)(zb + pp * 16 * RS + ks * 64); za[pp] = mfma16(sf, qk, za[pp]); }
        }
#pragma unroll
        for (int pp = 0; pp < NPW; ++pp) st_bf16x4(Y + (size_t)(tokc + i) * ldy + (NPW * ph + pp) * 16 + 4 * fq, ya[pp] + za[pp] * ex);
        {
            const float eE = __expf(lE[0]);
            bf16x8 vs[NPI][2];
#pragma unroll
            for (int pi = 0; pi < NPI; ++pi)
#pragma unroll
                for (int k2 = 0; k2 < 2; ++k2) { const u32x4 w = *(const LAS u32x4*)(vsb + pi * 64 * TS + k2 * 64); const int j0 = k2 * 32 + fq * 8;
                    const f32x4 t0 = *(const LAS f32x4*)(ldtt + j0), t1 = *(const LAS f32x4*)(ldtt + j0 + 4); u32x4 o;
                    o.x = cvt_pk_bf16(bf_lo(w.x) * t0[0], bf_hi(w.x) * t0[1]); o.y = cvt_pk_bf16(bf_lo(w.y) * t0[2], bf_hi(w.y) * t0[3]);
                    o.z = cvt_pk_bf16(bf_lo(w.z) * t1[0], bf_hi(w.z) * t1[1]); o.w = cvt_pk_bf16(bf_lo(w.w) * t1[2], bf_hi(w.w) * t1[3]);
                    vs[pi][k2] = as_bf16x8(o); }
#pragma unroll
            for (int q = 0; q < NKS; ++q) { const int nt = ph * NKS + q;
                bf16x8 kt[2];
#pragma unroll
                for (int k2 = 0; k2 < 2; ++k2) kt[k2] = *(const LAS bf16x8*)(ktb + q * 16 * TS + k2 * 64);
#pragma unroll
                for (int pi = 0; pi < NPI; ++pi) { sacc[pi][q] = sacc[pi][q] * eE;
#pragma unroll
                    for (int k2 = 0; k2 < 2; ++k2) sacc[pi][q] = mfma16(vs[pi][k2], kt[k2], sacc[pi][q]); }
                if (GPRE && (q & 1)) __builtin_amdgcn_sched_barrier(0);
            }
        }
        __syncthreads();
        if (has_next) {
            put_state(sacc);
            commit();
        }
    }
    if (sfin) {
#pragma unroll
        for (int pi = 0; pi < NPI; ++pi)
#pragma unroll
            for (int q = 0; q < NKS; ++q) { const int nt = ph * NKS + q; *(f32x4*)(sfin + (size_t)(nt * 16 + fr) * ldS + (it + 4 * pi) * 16 + 4 * fq) = sacc[pi][q]; }
    }
}
__device__ __forceinline__ void retg_item(const bf16_t* QR, const bf16_t* KR, float* GP, int c, int h, int it, int lane) {
    const int fr = lane & 15, fq = lane >> 4, tokc = c * 64;
    bf16x8 qf[8];
#pragma unroll
    for (int ks = 0; ks < 8; ++ks) qf[ks] = *(const bf16x8*)(QR + (size_t)(tokc + it * 16 + fr) * 1024 + h * 256 + ks * 32 + fq * 8);
#pragma unroll
    for (int jt = 0; jt < 4; ++jt) { f32x4 g = (f32x4){0.f, 0.f, 0.f, 0.f};
#pragma unroll
        for (int ks = 0; ks < 8; ++ks) { const bf16x8 kf = *(const bf16x8*)(KR + (size_t)(tokc + jt * 16 + fr) * 1024 + h * 256 + ks * 32 + fq * 8); g = mfma16(kf, qf[ks], g); }
        *(f32x4*)(GP + ((size_t)(((c * 4 + h) * 4 + it) * 4 + jt) * 64 + lane) * 4) = g; }
}
__device__ __forceinline__ void in1_phase(const Params& p, LAS unsigned char* lds, const EpiIn1& e) {
    unsigned char* ws = p.ws; const bf16_t* H = (const bf16_t*)(ws + O_H); const bf16_t* W = (const bf16_t*)(ws + O_W1IN);
    const int bx = (int)blockIdx.x, G = (int)gridDim.x; const bool fused = G == 256;
    for (int k = 0;; ++k) {
        int pm, pn; bool ok;
        if (fused) { ok = k < 3;
            if (bx < 192) { pm = bx >> 2; pn = 4 * k + (bx & 3); }
            else { const int t = (bx - 192) * 3 + k; pm = t >> 2; pn = 12 + (t & 3); } }
        else ok = tile_of(k * G + bx, T / BM, 16, pm, pn);
        if (!ok) break;
        gemm_tile(lds, H, W, 1024, pm * BM, pn * BM, e);
        if (fused && bx < 192 && k == 1) {
            const bf16_t* QR = (const bf16_t*)(ws + O_QR); const bf16_t* KR = (const bf16_t*)(ws + O_KR); float* GP = (float*)(ws + O_GP);
            const int wv = threadIdx.x >> 6, lane = threadIdx.x & 63;
            for (int u = wv; u < 16; u += 8) retg_item(QR, KR, GP, pm * 4 + (u >> 2), bx & 3, u & 3, lane);
        }
    }
}
__device__ __forceinline__ void retg_phase(const Params& p) {
    unsigned char* ws = p.ws; const bf16_t* QR = (const bf16_t*)(ws + O_QR); const bf16_t* KR = (const bf16_t*)(ws + O_KR); float* GP = (float*)(ws + O_GP);
    const int lane = threadIdx.x & 63, gw = blockIdx.x * 8 + (threadIdx.x >> 6), nwv = gridDim.x * 8;
    for (int idx = gw; idx < 192 * 4 * 4; idx += nwv) retg_item(QR, KR, GP, idx >> 4, (idx >> 2) & 3, idx & 3, lane);
}
__device__ __forceinline__ int next_item(unsigned* ctr, LAS unsigned char* lds) {
    LAS int* slot = (LAS int*)(lds + 896);
    if (threadIdx.x == 0) slot[0] = (int)atomicAdd(ctr, 1u);
    __syncthreads();
    const int v = slot[0];
    __syncthreads();
    return v;
}
__device__ __forceinline__ void ssd_phase(const Params& p, LAS unsigned char* lds, int rep) {
    unsigned char* ws = p.ws; unsigned* ctr = (unsigned*)(ws + O_CTL) + 0 + 2 * rep;
    const bf16_t* XC = (const bf16_t*)(ws + O_XC); const bf16_t* XT = (const bf16_t*)(ws + O_XT); bf16_t* YS = (bf16_t*)(ws + O_YS); const float* DT = (const float*)(ws + O_DT);
    for (;;) {
        const int it = next_item(ctr, lds); if (it >= 128 + 1024) break;
        int b, dir, h, tok0, nch; const float* s0 = nullptr; float* sfin = nullptr;
        if (it < 128) { b = it >> 5; dir = (it >> 4) & 1; h = it & 15; tok0 = TC + b * 1024; nch = 16; s0 = p.in[4] + (size_t)((b * 2 + dir) * 16 + h) * 128 * 64; }
        else { const int u = it - 128; b = u >> 5; dir = (u >> 4) & 1; h = u & 15; tok0 = b * 256; nch = 4; sfin = p.out + OUT_SSD + (size_t)((b * 2 + dir) * 16 + h) * 128 * 64; }
        const int g = h >> 3;
        scan_item<128, true, 64, false>(lds, XC + 1280 + g * 128, XC + 1024 + g * 128, 1536, XT + (size_t)(1024 + g * 128) * T, XT + (size_t)(h * 64) * T, tok0, nch, dir, s0, sfin, 64,
                             YS + (size_t)dir * T * 1024 + h * 64, 1024, DT + dir * 16 + h, p.in[18][dir * 16 + h], -__expf(p.in[17][dir * 16 + h]), nullptr);
    }
}
__device__ __forceinline__ void ret_phase(const Params& p, LAS unsigned char* lds, int rep) {
    unsigned char* ws = p.ws; unsigned* ctr = (unsigned*)(ws + O_CTL) + 1 + 2 * rep;
    const bf16_t* QR = (const bf16_t*)(ws + O_QR); const bf16_t* KR = (const bf16_t*)(ws + O_KR); const bf16_t* KRT = (const bf16_t*)(ws + O_KRT); const bf16_t* VRT = (const bf16_t*)(ws + O_VRT);
    bf16_t* YR = (bf16_t*)(ws + O_YR); const float* GP = (const float*)(ws + O_GP);
    int first_tile = 0;
    for (;;) {
        const int it = next_item(ctr, lds); if (it >= 128 + 1024) { first_tile = it; break; }
        int b, dir, h, sl, tok0, nch; const float* s0 = nullptr; float* sfin = nullptr;
        if (it < 128) { b = it >> 5; dir = (it >> 4) & 1; h = (it >> 2) & 3; sl = it & 3; tok0 = TC + b * 1024; nch = 16; s0 = p.in[5] + (size_t)((b * 2 + dir) * 4 + h) * 256 * 512 + sl * 128; }
        else { const int u = it - 128; b = u >> 5; dir = (u >> 4) & 1; h = (u >> 2) & 3; sl = u & 3; tok0 = b * 256; nch = 4; sfin = p.out + OUT_RET + (size_t)((b * 2 + dir) * 4 + h) * 256 * 512 + sl * 128; }
        const float x = p.in[30][dir * 4 + h]; const float lg = -softplusf(-x);
        scan_item<256, false, 128, true>(lds, QR + h * 256, KR + h * 256, 1024, KRT + (size_t)(h * 256) * T, VRT + (size_t)(h * 512 + sl * 128) * T, tok0, nch, dir, s0, sfin, 512,
                              YR + (size_t)dir * T * 2048 + h * 512 + sl * 128, 2048, nullptr, 0.f, lg, GP + (size_t)h * 16 * 256);
    }
    { const EpiIn1 e{(bf16_t*)(ws + O_QR), (bf16_t*)(ws + O_KR), (bf16_t*)(ws + O_KRT), (bf16_t*)(ws + O_VRT), (bf16_t*)(ws + O_GR)};
      for (int it = first_tile; it < 128 + 1024 + 384; it = next_item(ctr, lds)) { const int t = it - (128 + 1024);
          gemm_tile(lds, (const bf16_t*)(ws + O_H), (const bf16_t*)(ws + O_W1IN), 1024, (t >> 3) * 256, 4096 + (t & 7) * 256, e); } }
}

__device__ __forceinline__ void ssd_gate_phase(const Params& p) {
    unsigned char* ws = p.ws; const bf16_t* YS = (const bf16_t*)(ws + O_YS); const bf16_t* XC = (const bf16_t*)(ws + O_XC); const bf16_t* Z = (const bf16_t*)(ws + O_Z); bf16_t* MIX = (bf16_t*)(ws + O_MIX);
    const float* dsk = p.in[19]; const float* nw = p.in[20];
    const int lane = threadIdx.x & 63, gw = blockIdx.x * 8 + (threadIdx.x >> 6), nwv = gridDim.x * 8;
    for (int it = gw; it < T * 2; it += nwv) {
        const int tok = it >> 1, g = it & 1, ch = g * 512 + lane * 8;
        float a[8], b[8], x[8], z[8];
        unpack8(*(const u32x4*)(YS + (size_t)tok * 1024 + ch), a); unpack8(*(const u32x4*)(YS + (size_t)(T + tok) * 1024 + ch), b);
        unpack8(*(const u32x4*)(XC + (size_t)tok * 1536 + ch), x); unpack8(*(const u32x4*)(Z + (size_t)tok * 1024 + ch), z);
        const float d = dsk[ch >> 6]; float ss = 0.f;
#pragma unroll
        for (int e = 0; e < 8; ++e) { a[e] = (a[e] + b[e] + d * x[e]) * siluf(z[e]); ss += a[e] * a[e]; }
        ss = wave_sum(ss); const float rstd = rsqrtf(ss * (1.f / 512.f) + 1e-6f);
        const f32x4 w0 = *(const f32x4*)(nw + ch), w1 = *(const f32x4*)(nw + ch + 4);
        u32x4 o; o.x = cvt_pk_bf16(a[0] * rstd * w0[0], a[1] * rstd * w0[1]); o.y = cvt_pk_bf16(a[2] * rstd * w0[2], a[3] * rstd * w0[3]);
        o.z = cvt_pk_bf16(a[4] * rstd * w1[0], a[5] * rstd * w1[1]); o.w = cvt_pk_bf16(a[6] * rstd * w1[2], a[7] * rstd * w1[3]);
        *(u32x4*)(MIX + (size_t)tok * 1536 + 512 + ch) = o;
    }
}
__device__ __forceinline__ void ret_gate_phase(const Params& p) {
    unsigned char* ws = p.ws; const bf16_t* YR = (const bf16_t*)(ws + O_YR); const bf16_t* GR = (const bf16_t*)(ws + O_GR); bf16_t* RG = (bf16_t*)(ws + O_RG);
    const float* nw = p.in[31];
    const int lane = threadIdx.x & 63, gw = blockIdx.x * 8 + (threadIdx.x >> 6), nwv = gridDim.x * 8;
    for (int it = gw; it < T * 4; it += nwv) {
        const int tok = it >> 2, h = it & 3, ch = h * 512 + lane * 8;
        float a[8], b[8], gt[8];
        unpack8(*(const u32x4*)(YR + (size_t)tok * 2048 + ch), a); unpack8(*(const u32x4*)(YR + (size_t)(T + tok) * 2048 + ch), b); unpack8(*(const u32x4*)(GR + (size_t)tok * 2048 + ch), gt);
        float ss = 0.f;
#pragma unroll
        for (int e = 0; e < 8; ++e) { a[e] += b[e]; ss += a[e] * a[e]; }
        ss = wave_sum(ss); const float rstd = rsqrtf(ss * (1.f / 512.f) + 1e-6f);
        const f32x4 w0 = *(const f32x4*)(nw + ch), w1 = *(const f32x4*)(nw + ch + 4);
        float o[8];
#pragma unroll
        for (int e = 0; e < 8; ++e) o[e] = a[e] * rstd * (e < 4 ? w0[e] : w1[e - 4]) * siluf(gt[e]);
        u32x4 ow; ow.x = cvt_pk_bf16(o[0], o[1]); ow.y = cvt_pk_bf16(o[2], o[3]); ow.z = cvt_pk_bf16(o[4], o[5]); ow.w = cvt_pk_bf16(o[6], o[7]);
        *(u32x4*)(RG + (size_t)tok * 2048 + ch) = ow;
    }
}

#define XB_TMO      128
#define XB_XCNT(j)  (256  + 64 * (j))
#define XB_XSUB(j)  (1280 + 64 * (j))
#define XB_XGEN(j)  (2304 + 64 * (j))
#define XB_TOP      3328
#define XB_TOPGEN   3392
#define XCD_BAR_WORDS 3456
#define XB_SPIN_CAP (1u << 18)
__device__ __forceinline__ unsigned xb_ld(unsigned* p)              { return __hip_atomic_load(p, __ATOMIC_RELAXED, __HIP_MEMORY_SCOPE_AGENT); }
__device__ __forceinline__ unsigned xb_add(unsigned* p, unsigned v) { return __hip_atomic_fetch_add(p, v, __ATOMIC_RELAXED, __HIP_MEMORY_SCOPE_AGENT); }
__device__ __forceinline__ unsigned xb_xcc_id() { return (unsigned)__builtin_amdgcn_s_getreg((3 << 11) | 20) & 0xFu; }
#define XB_SPIN(cond, bar) do { unsigned _sp = 0; while (cond) { __builtin_amdgcn_s_sleep(1); \
    if ((++_sp & 255u) == 0u) { if (xb_ld(&(bar)[XB_TMO])) break; if (_sp > XB_SPIN_CAP) { atomicAdd(&(bar)[XB_TMO], 1u); break; } } } } while (0)
struct XcdBarrier { unsigned* bar; unsigned x; volatile LAS unsigned* st; };
__device__ __forceinline__ XcdBarrier xcd_barrier_post(unsigned* bar, volatile LAS unsigned* st) {
    XcdBarrier b; b.bar = bar; b.x = xb_xcc_id(); b.st = st;
    if (threadIdx.x == 0) (void)xb_add(&bar[XB_XCNT(b.x)], 1u);
    return b;
}
__device__ __forceinline__ void xcd_barrier_complete(unsigned* bar, unsigned x, unsigned& nloc, unsigned& nx) {
    const unsigned G = gridDim.x * gridDim.y * gridDim.z;
    unsigned sum, cnt, mine, sp = 0u;
    for (;;) {
        sum = 0u; cnt = 0u; mine = 0u;
#pragma unroll
        for (unsigned j = 0; j < 16; ++j) { const unsigned c = xb_ld(&bar[XB_XCNT(j)]); sum += c; cnt += (c > 0u) ? 1u : 0u; mine = (j == x) ? c : mine; }
        if (sum == G) break;
        __builtin_amdgcn_s_sleep(1);
        if ((++sp & 255u) == 0u) { if (xb_ld(&bar[XB_TMO])) break; if (sp > XB_SPIN_CAP) { atomicAdd(&bar[XB_TMO], 1u); break; } }
    }
    nloc = mine > 0u ? mine : 1u; nx = cnt > 0u ? cnt : 1u;
}
__device__ __forceinline__ void xcd_barrier(const XcdBarrier& b) {
    asm volatile("s_waitcnt vmcnt(0)" ::: "memory");
    __syncthreads();
    if (threadIdx.x == 0) {
        unsigned* bar = b.bar;
        __builtin_amdgcn_s_waitcnt(0);
        unsigned nloc = b.st[0], nx = b.st[1];
        if (nloc == 0u) { xcd_barrier_complete(bar, b.x, nloc, nx); b.st[0] = nloc; b.st[1] = nx; }
        const unsigned old = xb_add(&bar[XB_XSUB(b.x)], 1u);
        const unsigned gen = old / nloc;
        if (old + 1u == (gen + 1u) * nloc) {
            __builtin_amdgcn_fence(__ATOMIC_RELEASE, "agent");
            asm volatile("s_waitcnt vmcnt(0)" ::: "memory");
            const unsigned og = xb_add(&bar[XB_TOP], 1u);
            const unsigned tg = og / nx;
            if (og + 1u == (tg + 1u) * nx) xb_add(&bar[XB_TOPGEN], 1u);
            else XB_SPIN(xb_ld(&bar[XB_TOPGEN]) == tg, bar);
            __builtin_amdgcn_fence(__ATOMIC_ACQUIRE, "agent");
            xb_add(&bar[XB_XGEN(b.x)], 1u);
            asm volatile("s_waitcnt vmcnt(0)" ::: "memory");
        } else {
            XB_SPIN(xb_ld(&bar[XB_XGEN(b.x)]) == gen, bar);
            __builtin_amdgcn_fence(__ATOMIC_ACQUIRE, "agent");
            asm volatile("s_waitcnt vmcnt(0)" ::: "memory");
        }
    }
    __syncthreads();
}

constexpr int N_PHASES = 19;
__global__ void __launch_bounds__(NTHR) fwd_megakernel(Params p_arg) {
    const Params& p = *(const Params*)__builtin_amdgcn_kernarg_segment_ptr();
    extern __shared__ __attribute__((aligned(16))) unsigned char lds_raw[];
    LAS unsigned char* lds = (LAS unsigned char*)lds_raw;
    cg::grid_group grid = cg::this_grid();
    if (threadIdx.x < 4) ((LAS unsigned*)(lds + LDS_XB_OFF))[threadIdx.x] = 0u;
    __syncthreads();
    (void)xcd_barrier_post((unsigned*)(p.ws + O_CTL) + 256, (volatile LAS unsigned*)(lds + LDS_XB_OFF));
    unsigned char* ws = p.ws;
    float* MOD = (float*)(ws + O_MOD); bf16_t* H = (bf16_t*)(ws + O_H); float* XA = (float*)(ws + O_XA);
#ifdef ONLY_PHASE
#define PH_ON(k) ((k) == ONLY_PHASE)
#else
#define PH_ON(k) (p.ph_lo <= (k) && (k) < p.ph_hi)
#endif
#ifndef PROBE_MASK
#define PROBE_MASK 0
#endif
#define PH_BEGIN(k) if (PH_ON(k)) { for (int rep = 0; rep <= ((PROBE_MASK >> (k)) & 1); ++rep) {
#define PH_END(k) } } if (p.ph_lo <= (k) && (k) + 1 < p.ph_hi) { if ((k) == 0 && p.ph_lo < 0) grid.sync(); else { XcdBarrier xb_; xb_.bar = (unsigned*)(p.ws + O_CTL) + 256; xb_.x = xb_xcc_id(); xb_.st = (volatile LAS unsigned*)(lds + LDS_XB_OFF); xcd_barrier(xb_); } }
    PH_BEGIN(0) prep_phase(p, lds, 0, (int)blockIdx.x, (int)gridDim.x);
        if (gridDim.x <= 192) { prep_phase(p, lds, 1, (int)blockIdx.x, (int)gridDim.x); prep_phase(p, lds, 2, (int)blockIdx.x, (int)gridDim.x); } PH_END(0)
    PH_BEGIN(1) norm_phase(p.in[0], p.in[1], p.in[8], MOD, 0, 1024, H, nullptr); PH_END(1)
    PH_BEGIN(2) EpiIn0 e{(bf16_t*)(ws + O_Q0), (bf16_t*)(ws + O_K0), (bf16_t*)(ws + O_V0T), (bf16_t*)(ws + O_Z), (bf16_t*)(ws + O_XBC), (float*)(ws + O_DT), p.out + OUT_K, p.out + OUT_V};
        gemm_phase(lds, H, (const bf16_t*)(ws + O_W0IN), 4096, 1024, e); PH_END(2)
    PH_BEGIN(3) conv_phase(p, lds); na_phase(p, lds); PH_END(3)
    PH_BEGIN(4) ssd_phase(p, lds, rep); PH_END(4)
    PH_BEGIN(5) ssd_gate_phase(p); PH_END(5)
    PH_BEGIN(6) EpiRes e{p.in[0], p.in[1], XA, MOD + 2048}; gemm_phase(lds, (const bf16_t*)(ws + O_MIX), (const bf16_t*)(ws + O_W0OUT), 1024, 1536, e, &p, gridDim.x > 192 ? 1 : 0); PH_END(6)
    PH_BEGIN(7) norm_phase(XA, XA + (size_t)TC * 1024, p.in[9], MOD, 3072, 4096, H, nullptr); PH_END(7)
    PH_BEGIN(8) EpiSwiglu e{(bf16_t*)(ws + O_HID)}; gemm_phase(lds, H, (const bf16_t*)(ws + O_W0UP), 5632, 1024, e); PH_END(8)
    PH_BEGIN(9) EpiRes e{XA, XA + (size_t)TC * 1024, XA, MOD + 5120}; gemm_phase(lds, (const bf16_t*)(ws + O_HID), (const bf16_t*)(ws + O_W0DN), 1024, 2816, e, &p, gridDim.x > 192 ? 2 : 0); PH_END(9)
    PH_BEGIN(10) norm_phase(XA, XA + (size_t)TC * 1024, p.in[24], MOD + 5 * 6144, 0, 1024, H, nullptr); PH_END(10)
    PH_BEGIN(11) EpiIn1 e{(bf16_t*)(ws + O_QR), (bf16_t*)(ws + O_KR), (bf16_t*)(ws + O_KRT), (bf16_t*)(ws + O_VRT), (bf16_t*)(ws + O_GR)};
        in1_phase(p, lds, e);
        if (gridDim.x != 256) { XcdBarrier xb_; xb_.bar = (unsigned*)(p.ws + O_CTL) + 256; xb_.x = xb_xcc_id(); xb_.st = (volatile LAS unsigned*)(lds + LDS_XB_OFF); xcd_barrier(xb_); retg_phase(p); } PH_END(11)
    PH_BEGIN(12) ret_phase(p, lds, rep); PH_END(12)
    PH_BEGIN(13) ret_gate_phase(p); PH_END(13)
    PH_BEGIN(14) EpiRes e{XA, XA + (size_t)TC * 1024, XA, MOD + 5 * 6144 + 2048}; gemm_phase(lds, (const bf16_t*)(ws + O_RG), (const bf16_t*)(ws + O_W1OUT), 1024, 2048, e); PH_END(14)
    PH_BEGIN(15) norm_phase(XA, XA + (size_t)TC * 1024, p.in[25], MOD + 5 * 6144, 3072, 4096, H, nullptr); PH_END(15)
    PH_BEGIN(16) EpiSwiglu e{(bf16_t*)(ws + O_HID)}; gemm_phase(lds, H, (const bf16_t*)(ws + O_W1UP), 5632, 1024, e); PH_END(16)
    PH_BEGIN(17) EpiRes e{XA, XA + (size_t)TC * 1024, XA, MOD + 5 * 6144 + 5120}; gemm_phase(lds, (const bf16_t*)(ws + O_HID), (const bf16_t*)(ws + O_W1DN), 1024, 2816, e); PH_END(17)
    PH_BEGIN(18) norm_phase(XA, XA + (size_t)TC * 1024, p.in[35], nullptr, 0, 0, nullptr, p.out + OUT_Y); PH_END(18)
}

extern "C" void kernel_launch(void* const* d_in, const int* in_sizes, int n_in, void* d_out, int out_size, void* d_ws, size_t ws_size, hipStream_t stream) {
    static int grid_blocks = 0;
    if (grid_blocks == 0) {
        if (n_in != 36 || ws_size < WS_END) { fprintf(stderr, "kernel_launch: unexpected n_in %d / ws %zu (need %zu)\n", n_in, ws_size, (size_t)WS_END); grid_blocks = -1; return; }
        int dev = 0, cus = 0, per_cu = 0;
        hipGetDevice(&dev); hipDeviceGetAttribute(&cus, hipDeviceAttributeMultiprocessorCount, dev);
        if (hipFuncSetAttribute((const void*)fwd_megakernel, hipFuncAttributeMaxDynamicSharedMemorySize, LDS_BYTES) != hipSuccess) { fprintf(stderr, "kernel_launch: hipFuncSetAttribute failed\n"); grid_blocks = -1; return; }
        if (hipOccupancyMaxActiveBlocksPerMultiprocessor(&per_cu, (const void*)fwd_megakernel, NTHR, LDS_BYTES) != hipSuccess || per_cu < 1) { fprintf(stderr, "kernel_launch: occupancy query failed (%d)\n", per_cu); grid_blocks = -1; return; }
        grid_blocks = cus * per_cu;
    }
    if (grid_blocks < 0) return;
    hipMemsetAsync((char*)d_ws + O_CTL, 0, 16384, stream);
    Params p{};
    for (int i = 0; i < 36; ++i) p.in[i] = (const float*)d_in[i];
    p.out = (float*)d_out; p.ws = (unsigned char*)d_ws;
#if N_SPLIT
    for (int ph = 0; ph < N_PHASES; ++ph) { p.ph_lo = ph; p.ph_hi = ph + 1; void* args[] = {&p};
        hipError_t e = hipLaunchCooperativeKernel((void*)fwd_megakernel, dim3(grid_blocks), dim3(NTHR), args, LDS_BYTES, stream);
        if (e != hipSuccess) { fprintf(stderr, "launch failed: %s\n", hipGetErrorString(e)); break; } }
#else
    p.ph_lo = 0; p.ph_hi = N_PHASES; void* args[] = {&p};
    hipError_t e = hipLaunchCooperativeKernel((void*)fwd_megakernel, dim3(grid_blocks), dim3(NTHR), args, LDS_BYTES, stream);
    if (e != hipSuccess) fprintf(stderr, "cooperative launch failed: %s (grid %d)\n", hipGetErrorString(e), grid_blocks);
#endif
}
```
